# Optimizing an MI355X kernel written in HIP

```python
import math
import jax
import jax.numpy as jnp
from jax import lax
import numpy as np

D_MODEL = 2048
BATCH = 4
SEQ = 2048
DEPTH = 4
DEC_BATCH = 8
DEC_SEQ = 4
PAST_LEN = 16384
PAGE_SIZE = 128

W_A = D_MODEL // 4
CONV_K = 31
HD_B = 128
W_B = D_MODEL // 4
HB = W_B // HD_B
DIL_CONFIGS = ((128, 1), (512, 4), (2048, 16))
N_DIL = len(DIL_CONFIGS)
Q_BLOCK = 128
W_C = D_MODEL // 2
HC = 4
DV_C = W_C // HC
DK_C = DV_C // 2
RET_CHUNK = 128
D_MIX = W_A + W_B + W_C
D_IN = 2 * W_A + 3 * N_DIL * W_B + 2 * HC * DK_C + 2 * W_C
D_FF = 4 * D_MODEL
ROPE_THETA = 10000.0
ALPHA = (2 * DEPTH) ** 0.25
BETA = (8 * DEPTH) ** -0.25
LN_EPS = 1e-5
NEG_INF = -1e30

kernel_name = 'hymba_conv_dilated_retention_decode_step'


def layer_norm(x, g=None, b=None):
    x32 = x.astype(jnp.float32)
    mu = x32.mean(-1, keepdims=True)
    var = jnp.square(x32 - mu).mean(-1, keepdims=True)
    y = (x32 - mu) * lax.rsqrt(var + LN_EPS)
    if g is not None:
        y = y * g.astype(jnp.float32) + b.astype(jnp.float32)
    return y.astype(x.dtype)


def rope(x, pos):
    half = x.shape[-1] // 2
    inv = ROPE_THETA ** (-jnp.arange(half, dtype=jnp.float32) / half)
    ang = pos.astype(jnp.float32)[:, None] * inv[None, :]
    cos = jnp.cos(ang)[:, None, :]
    sin = jnp.sin(ang)[:, None, :]
    x32 = x.astype(jnp.float32)
    x1, x2 = x32[..., :half], x32[..., half:]
    return jnp.concatenate([x1 * cos - x2 * sin, x2 * cos + x1 * sin], axis=-1).astype(x.dtype)


def split_proj(z):
    sizes = (W_A, W_A, N_DIL * W_B, N_DIL * W_B, N_DIL * W_B, HC * DK_C, HC * DK_C, W_C, W_C)
    return jnp.split(z, np.cumsum(sizes)[:-1].tolist(), axis=-1)


def project_heads(z, pos):
    a, ga, qb, kb, vb, qc, kc, vc, gc = split_proj(z)
    B_, T = z.shape[0], z.shape[1]
    u = a * jax.nn.sigmoid(ga)
    qb = rope(qb.reshape(B_, T, N_DIL * HB, HD_B), pos).reshape(B_, T, N_DIL, HB, HD_B)
    kb = rope(kb.reshape(B_, T, N_DIL * HB, HD_B), pos).reshape(B_, T, N_DIL, HB, HD_B)
    vb = vb.reshape(B_, T, N_DIL, HB, HD_B)
    qc = rope(qc.reshape(B_, T, HC, DK_C), pos).astype(jnp.float32)
    kc = rope(kc.reshape(B_, T, HC, DK_C), pos).astype(jnp.float32) * (DK_C ** -0.5)
    vc = vc.reshape(B_, T, HC, DV_C).astype(jnp.float32)
    return u, qb, kb, vb, qc, kc, vc, gc


def causal_dwconv(u_ext, w, b):
    y = lax.conv_general_dilated(u_ext, w[:, None, :].astype(u_ext.dtype), (1,), 'VALID',
                                 dimension_numbers=('NWC', 'WIO', 'NWC'),
                                 feature_group_count=u_ext.shape[-1])
    return y + b


def conv_tail(y, g, b):
    return jax.nn.silu(layer_norm(y, g, b))


def dilated_prompt(q, k, v, window, dil):
    B_, T, H, hd = q.shape
    nw = window // dil
    S = T // dil
    nblk = -(-S // Q_BLOCK)
    nprev = -(-nw // Q_BLOCK)
    pad_r = nblk * Q_BLOCK - S

    def streams(x):
        return x.reshape(B_, S, dil, H, hd).transpose(0, 2, 1, 3, 4)

    qs = jnp.pad(streams(q), ((0, 0), (0, 0), (0, pad_r), (0, 0), (0, 0)))
    qs = qs.reshape(B_, dil, nblk, Q_BLOCK, H, hd)

    def key_blocks(x):
        xp = jnp.pad(streams(x), ((0, 0), (0, 0), (nprev * Q_BLOCK, pad_r), (0, 0), (0, 0)))
        xp = xp.reshape(B_, dil, nblk + nprev, Q_BLOCK, H, hd)
        return jnp.concatenate([xp[:, :, j:j + nblk] for j in range(nprev + 1)], axis=3)

    kbk, vbk = key_blocks(k), key_blocks(v)
    qi = jnp.arange(Q_BLOCK)
    ki = jnp.arange((nprev + 1) * Q_BLOCK)
    blk = jnp.arange(nblk)
    k_idx = blk[:, None, None] * Q_BLOCK + ki[None, None, :] - nprev * Q_BLOCK
    dist = (qi[None, :, None] + nprev * Q_BLOCK) - ki[None, None, :]
    mask = (dist >= 0) & (dist <= nw) & (k_idx >= 0)
    s = jnp.einsum('bgnqhd,bgnkhd->bgnhqk', qs, kbk).astype(jnp.float32) * (hd ** -0.5)
    s = jnp.where(mask[None, None, :, None], s, NEG_INF)
    m = s.max(-1, keepdims=True)
    p = jnp.exp(s - m)
    den = p.sum(-1, keepdims=True)
    o = jnp.einsum('bgnhqk,bgnkhd->bgnqhd', p / den, vbk.astype(jnp.float32))
    lse = (m + jnp.log(den))[..., 0]
    o = o.reshape(B_, dil, nblk * Q_BLOCK, H, hd)[:, :, :S].transpose(0, 2, 1, 3, 4).reshape(B_, T, H, hd)
    lse = lse.transpose(0, 1, 2, 4, 3).reshape(B_, dil, nblk * Q_BLOCK, H)[:, :, :S]
    lse = lse.transpose(0, 2, 1, 3).reshape(B_, T, H)
    return o.astype(q.dtype), lse


def dilated_sample(q, k_all, v_all, window, dil):
    Tn, hd = q.shape[1], q.shape[-1]
    L = k_all.shape[1] - Tn
    nw = window // dil
    idx = L + jnp.arange(Tn)[:, None] - dil * jnp.arange(nw + 1)[None, :]
    valid = idx >= 0
    idx = jnp.maximum(idx, 0)
    kg = k_all[:, idx]
    vg = v_all[:, idx]
    s = jnp.einsum('bqhd,bqjhd->bhqj', q, kg).astype(jnp.float32) * (hd ** -0.5)
    s = jnp.where(valid[None, None], s, NEG_INF)
    m = s.max(-1, keepdims=True)
    p = jnp.exp(s - m)
    den = p.sum(-1, keepdims=True)
    o = jnp.einsum('bhqj,bqjhd->bqhd', p / den, vg.astype(jnp.float32))
    lse = (m + jnp.log(den))[..., 0].transpose(0, 2, 1)
    return o.astype(q.dtype), lse


def merge_dilations(outs, lses):
    wts = jax.nn.softmax(jnp.stack(lses, 0), axis=0)
    o = jnp.einsum('gbth,gbthd->bthd', wts, jnp.stack(outs, 0).astype(jnp.float32))
    return o.reshape(o.shape[0], o.shape[1], W_B).astype(outs[0].dtype)


def retention_log_decay():
    return jnp.log1p(-jnp.exp2(-5.0 - jnp.arange(HC, dtype=jnp.float32)))


def retention_chunk(S, q, k, v, log_gamma):
    C = q.shape[1]
    n = jnp.arange(C, dtype=jnp.float32)
    diff = n[:, None] - n[None, :]
    decay = jnp.where(diff >= 0, jnp.exp(log_gamma[:, None, None] * jnp.maximum(diff, 0.0)), 0.0)
    inner = jnp.exp(log_gamma[None, :] * (n[:, None] + 1.0))
    kdec = jnp.exp(log_gamma[None, :] * (C - 1.0 - n[:, None]))
    cdec = jnp.exp(log_gamma * C)
    sc = jnp.einsum('bnhd,bmhd->bhnm', q, k) * decay[None]
    o = jnp.einsum('bhnm,bmhe->bnhe', sc, v) + jnp.einsum('bnhd,bhde->bnhe', q, S) * inner[None, :, :, None]
    S_new = S * cdec[None, :, None, None] + jnp.einsum('bmhd,bmhe->bhde', k * kdec[None, :, :, None], v)
    return S_new, o


def retention_prompt(q, k, v, log_gamma):
    B_, T = q.shape[0], q.shape[1]
    nc = T // RET_CHUNK

    def to_chunks(x):
        return x.reshape(B_, nc, RET_CHUNK, x.shape[2], x.shape[3]).swapaxes(0, 1)

    S0 = jnp.zeros((B_, HC, DK_C, DV_C), jnp.float32)
    S, o = lax.scan(lambda St, inp: retention_chunk(St, inp[0], inp[1], inp[2], log_gamma),
                    S0, (to_chunks(q), to_chunks(k), to_chunks(v)))
    o = o.swapaxes(0, 1).reshape(B_, T, HC, DV_C)
    return o, S


def retention_out(o, gate):
    B_, T = o.shape[0], o.shape[1]
    gn = layer_norm(o).reshape(B_, T, W_C)
    return jax.nn.silu(gate) * gn.astype(gate.dtype)


def mix_prompt(z, pos, conv_w_l, conv_b_l, conv_g_l, conv_beta_l, log_gamma):
    u, qb, kb, vb, qc, kc, vc, gc = project_heads(z, pos)
    T = z.shape[1]
    u_ext = jnp.pad(u, ((0, 0), (CONV_K - 1, 0), (0, 0)))
    ya = conv_tail(causal_dwconv(u_ext, conv_w_l, conv_b_l), conv_g_l, conv_beta_l)
    outs, lses, wins = [], [], []
    for g, (window, dil) in enumerate(DIL_CONFIGS):
        o, lse = dilated_prompt(qb[:, :, g], kb[:, :, g], vb[:, :, g], window, dil)
        outs.append(o)
        lses.append(lse)
        L = min(window, T)
        wins.append(jnp.stack([kb[:, T - L:, g], vb[:, T - L:, g]], axis=2))
    yb = merge_dilations(outs, lses)
    oc, S = retention_prompt(qc, kc, vc, log_gamma)
    yc = retention_out(oc, gc)
    y = jnp.concatenate([ya, yb, yc], axis=-1)
    return y, (u_ext[:, T:], wins, S)


def mix_sample(z, pos, conv_buf, win_bufs, S, conv_w_l, conv_b_l, conv_g_l, conv_beta_l, log_gamma):
    u, qb, kb, vb, qc, kc, vc, gc = project_heads(z, pos)
    Tn = z.shape[1]
    u_ext = jnp.concatenate([conv_buf.astype(u.dtype), u], axis=1)
    ya = conv_tail(causal_dwconv(u_ext, conv_w_l, conv_b_l), conv_g_l, conv_beta_l)
    outs, lses, wins = [], [], []
    for g, (window, dil) in enumerate(DIL_CONFIGS):
        buf = win_bufs[g].astype(kb.dtype)
        k_all = jnp.concatenate([buf[:, :, 0], kb[:, :, g]], axis=1)
        v_all = jnp.concatenate([buf[:, :, 1], vb[:, :, g]], axis=1)
        o, lse = dilated_sample(qb[:, :, g], k_all, v_all, window, dil)
        outs.append(o)
        lses.append(lse)
        wins.append(jnp.stack([k_all[:, Tn:], v_all[:, Tn:]], axis=2))
    yb = merge_dilations(outs, lses)
    S_new, oc = retention_chunk(S.astype(jnp.float32), qc, kc, vc, log_gamma)
    yc = retention_out(oc, gc)
    y = jnp.concatenate([ya, yb, yc], axis=-1)
    return y, (u_ext[:, Tn:], wins, S_new)


def decoder_layer(x, c, mix_fn, w_ada_l, b_ada_l, w_in_l, w_o_l, ln1_g_l, ln1_b_l,
                  w_up_l, w_down_l, ln2_g_l, ln2_b_l):
    mod = jax.nn.silu(c) @ w_ada_l + b_ada_l
    sh1, sc1, g1, sh2, sc2, g2 = jnp.split(mod, 6, axis=-1)
    h = x * (1.0 + sc1[:, None]) + sh1[:, None]
    y, states = mix_fn(h @ w_in_l)
    x = layer_norm(ALPHA * x + g1[:, None] * (y @ w_o_l), ln1_g_l, ln1_b_l)
    h = x * (1.0 + sc2[:, None]) + sh2[:, None]
    f = jnp.square(jax.nn.relu(h @ w_up_l)) @ w_down_l
    x = layer_norm(ALPHA * x + g2[:, None] * f, ln2_g_l, ln2_b_l)
    return x, states


def setup_inputs(seed: int = 0) -> dict:
    key = jax.random.key(seed)
    ks = jax.random.split(key, 24)

    def nrm(k, shape, scale=1.0):
        return jax.random.normal(k, shape, jnp.float32) * scale

    win_len = [min(w, PAST_LEN) for w, _ in DIL_CONFIGS]
    return {
        'x_prompt': nrm(ks[0], (BATCH, SEQ, D_MODEL)),
        'x_sample': nrm(ks[1], (DEC_BATCH, DEC_SEQ, D_MODEL)),
        'cache_conv': nrm(ks[2], (DEPTH, DEC_BATCH, CONV_K - 1, W_A), 0.5),
        'cache_win1': nrm(ks[3], (DEPTH, DEC_BATCH, win_len[0], 2, HB, HD_B)),
        'cache_win2': nrm(ks[4], (DEPTH, DEC_BATCH, win_len[1], 2, HB, HD_B)),
        'cache_win3': nrm(ks[5], (DEPTH, DEC_BATCH, win_len[2], 2, HB, HD_B)),
        'state_ret': nrm(ks[6], (DEPTH, DEC_BATCH, HC, DK_C, DV_C), 0.5),
        'c_prompt': nrm(ks[7], (BATCH, D_MODEL)),
        'c_sample': nrm(ks[8], (DEC_BATCH, D_MODEL)),
        'w_ada': nrm(ks[9], (DEPTH, D_MODEL, 6 * D_MODEL), 0.5 * D_MODEL ** -0.5),
        'b_ada': nrm(ks[10], (DEPTH, 6 * D_MODEL), 0.02),
        'w_in': nrm(ks[11], (DEPTH, D_MODEL, D_IN), D_MODEL ** -0.5),
        'conv_w': nrm(ks[12], (DEPTH, CONV_K, W_A), CONV_K ** -0.5),
        'conv_b': nrm(ks[13], (DEPTH, W_A), 0.02),
        'conv_ln_g': 1.0 + nrm(ks[14], (DEPTH, W_A), 0.02),
        'conv_ln_b': nrm(ks[15], (DEPTH, W_A), 0.02),
        'w_o': nrm(ks[16], (DEPTH, D_MIX, D_MODEL), BETA * D_MIX ** -0.5),
        'ln1_g': 1.0 + nrm(ks[17], (DEPTH, D_MODEL), 0.02),
        'ln1_b': nrm(ks[18], (DEPTH, D_MODEL), 0.02),
        'w_up': nrm(ks[19], (DEPTH, D_MODEL, D_FF), D_MODEL ** -0.5),
        'w_down': nrm(ks[20], (DEPTH, D_FF, D_MODEL), BETA * D_FF ** -0.5),
        'ln2_g': 1.0 + nrm(ks[21], (DEPTH, D_MODEL), 0.02),
        'ln2_b': nrm(ks[22], (DEPTH, D_MODEL), 0.02),
    }


def reference(x_prompt, x_sample, cache_conv, cache_win1, cache_win2, cache_win3, state_ret,
              c_prompt, c_sample, w_ada, b_ada, w_in, conv_w, conv_b, conv_ln_g, conv_ln_b,
              w_o, ln1_g, ln1_b, w_up, w_down, ln2_g, ln2_b):
    log_gamma = retention_log_decay()
    pos_p = jnp.arange(x_prompt.shape[1], dtype=jnp.int32)
    pos_s = PAST_LEN + jnp.arange(x_sample.shape[1], dtype=jnp.int32)
    xp, xs = x_prompt, x_sample
    conv_p, conv_s, ret_p, ret_s = [], [], [], []
    win_p = [[] for _ in DIL_CONFIGS]
    win_s = [[] for _ in DIL_CONFIGS]
    for l in range(DEPTH):
        conv_l = (conv_w[l], conv_b[l], conv_ln_g[l], conv_ln_b[l])
        layer_w = (w_ada[l], b_ada[l], w_in[l], w_o[l], ln1_g[l], ln1_b[l],
                   w_up[l], w_down[l], ln2_g[l], ln2_b[l])
        bufs = (cache_win1[l], cache_win2[l], cache_win3[l])
        xp, (cp, wp, sp) = decoder_layer(
            xp, c_prompt, lambda z: mix_prompt(z, pos_p, *conv_l, log_gamma), *layer_w)
        xs, (cs, ws, ss) = decoder_layer(
            xs, c_sample, lambda z: mix_sample(z, pos_s, cache_conv[l], bufs, state_ret[l], *conv_l, log_gamma),
            *layer_w)
        conv_p.append(cp)
        conv_s.append(cs)
        ret_p.append(sp)
        ret_s.append(ss)
        for g in range(N_DIL):
            win_p[g].append(wp[g])
            win_s[g].append(ws[g])
    conv_prompt = jnp.stack(conv_p, 0)
    conv_sample = jnp.stack(conv_s, 0)
    win1_prompt = jnp.stack(win_p[0], 0)
    win1_sample = jnp.stack(win_s[0], 0)
    win2_prompt = jnp.stack(win_p[1], 0)
    win2_sample = jnp.stack(win_s[1], 0)
    win3_prompt = jnp.stack(win_p[2], 0)
    win3_sample = jnp.stack(win_s[2], 0)
    ret_prompt = jnp.stack(ret_p, 0)
    ret_sample = jnp.stack(ret_s, 0)
    return (xp, xs, conv_prompt, conv_sample, win1_prompt, win1_sample, win2_prompt, win2_sample,
            win3_prompt, win3_sample, ret_prompt, ret_sample)
```

```cpp
#include <hip/hip_runtime.h>
#include <cstdio>
#include <cstdint>

#ifndef PROBE_DUP
#define PROBE_DUP 0x0u
#endif
#define DUP(k) ((int)((PROBE_DUP >> (k)) & 1u))
#ifndef MK_ONE_LAUNCH
#define MK_ONE_LAUNCH 1
#endif

constexpr int DM = 2048, NB = 4, SEQ = 2048, DEPTH = 4, NBS = 8, TS = 4, PAST = 16384;
constexpr int WA = 512, CONVK = 31, HDB = 128, WB = 512, NHB = 4, NDIL = 3;
constexpr int WC = 1024, NHC = 4, DVC = 256, DKC = 128, RCH = 128, NCH = SEQ / RCH;
constexpr int DIN = 8704, DFF = 8192;
constexpr int MP = NB * SEQ;
constexpr int MS = NBS * TS;
constexpr int MT = MP + MS;
constexpr int OFF_A = 0, OFF_GA = 512, OFF_QB = 1024, OFF_KB = 2560, OFF_VB = 4096, OFF_QC = 5632, OFF_KC = 6144, OFF_VC = 6656, OFF_GC = 7680;
constexpr float LN_EPS = 1e-5f;
constexpr float ALPHA = 1.681792830507429f;
constexpr float SQ_ATT = 0.12751743082459868f;
constexpr float KS_RET = 0.08838834764831845f;
constexpr float LOG2E = 1.4426950408889634f;
__device__ __forceinline__ float lg2_gamma(int h) { return h == 0 ? -0.04580368961312479f : h == 1 ? -0.02272007650008353f : h == 2 ? -0.011315313227834146f : -0.005646563141142063f; }

constexpr size_t O_YP = 0, O_YS = O_YP + (size_t)MP * DM, O_CP = O_YS + (size_t)MS * DM, O_CS = O_CP + (size_t)DEPTH * NB * 30 * WA,
    O_W1P = O_CS + (size_t)DEPTH * NBS * 30 * WA, O_W1S = O_W1P + (size_t)DEPTH * NB * 128 * 1024, O_W2P = O_W1S + (size_t)DEPTH * NBS * 128 * 1024,
    O_W2S = O_W2P + (size_t)DEPTH * NB * 512 * 1024, O_W3P = O_W2S + (size_t)DEPTH * NBS * 512 * 1024, O_W3S = O_W3P + (size_t)DEPTH * NB * 2048 * 1024,
    O_RP = O_W3S + (size_t)DEPTH * NBS * 2048 * 1024, O_RS = O_RP + (size_t)DEPTH * NB * NHC * DKC * DVC, O_END = O_RS + (size_t)DEPTH * NBS * NHC * DKC * DVC;
static_assert(O_END == 155992064ull, "output size");

constexpr size_t MiB = 1u << 20;
constexpr size_t WS_CTL = 0, CTL_ZERO_BYTES = 1 * MiB;
constexpr size_t WS_MOD = 1 * MiB;
constexpr size_t WS_ROPE = 4 * MiB;
constexpr size_t WS_WIN = 8 * MiB;
constexpr size_t WS_WIN8 = 108 * MiB;
constexpr size_t WS_WSCI = 3 * MiB + 640 * 1024;
constexpr int NIN16 = 5632, NIN8 = 3072;
constexpr size_t WS_WO = 144 * MiB;
constexpr size_t WS_WUP = 176 * MiB;
constexpr size_t WS_WDN = 304 * MiB;
constexpr size_t WS_X = 432 * MiB;
constexpr size_t WS_H = 498 * MiB;
constexpr size_t WS_Z = 532 * MiB;
constexpr size_t WS_Y = 668 * MiB;
constexpr size_t WS_F = 702 * MiB;
constexpr size_t WS_ATTO = 830 * MiB;
constexpr size_t WS_ATTL = 854 * MiB;
constexpr size_t WS_KV = 855 * MiB;
constexpr size_t WS_ZS = 887 * MiB;
constexpr size_t WS_TS = 889 * MiB;
constexpr size_t WS_FS = 890 * MiB;
constexpr size_t WS_X2 = 891 * MiB;
constexpr size_t WS_H2 = 957 * MiB;
constexpr size_t WS_H8 = 991 * MiB;
constexpr size_t WS_WSC = 3 * MiB + 512 * 1024;
constexpr size_t WS_HSC = 3 * MiB + 768 * 1024;
constexpr size_t WS_END = 1008 * MiB;
constexpr int CW_BAR = 4096;

constexpr int SCR_BYTES = 143360;
constexpr int MISC_OFF = SCR_BYTES;
constexpr int LDS_BYTES = 147456;
constexpr int NWAVES = 8, NTHR = 512;
__host__ __device__ __forceinline__ int map16(int j) { return j < 4 ? j : j < 16 ? j + 6 : j + 8; }
__host__ __device__ __forceinline__ int map8(int j) { return j < 6 ? j + 4 : j < 8 ? j + 16 : j + 22; }
__host__ __device__ __forceinline__ int pos16(int c) { return map16(c >> 8) * 256 + (c & 255); }
__host__ __device__ __forceinline__ int pos8(int c) { return map8(c >> 8) * 256 + (c & 255); }
namespace pg8 {
#define PG8_LAS __attribute__((address_space(3)))
typedef unsigned short bf16_t;
typedef short bf16x8 __attribute__((ext_vector_type(8)));
typedef float f32x4 __attribute__((ext_vector_type(4)));
typedef unsigned u32x4 __attribute__((ext_vector_type(4)));
typedef int i32x4_t __attribute__((ext_vector_type(4)));
constexpr int BM = 256, BK = 64, HALF = 128, HTB = HALF * BK * 2  , STAGE_BYTES = 8 * HTB, NXCD = 8, WGM = 8;

__host__ __device__ __forceinline__ int lds_byte(int r, int c) { const int st = (r >> 4) * 2 + (c >> 5), rr = r & 15, cc = c & 31, ob = rr * 64 + cc * 2; return st * 1024 + (ob ^ (((ob >> 9) & 1) << 5)); }
__host__ __device__ __forceinline__ void stage_rc(int b, int& R, int& C) { const int st = b / 1024, sb = b % 1024, swz = sb ^ (((sb >> 9) & 1) << 5); R = (st >> 1) * 16 + swz / 64; C = (st & 1) * 32 + (swz % 64) / 2; }
__host__ __device__ __forceinline__ int perm32(int rho) { const int n = rho >> 4, i = rho & 15; return 8 * (i >> 2) + 4 * n + (i & 3); }

struct Unit { int pm, pn; };
struct Gemm { const bf16_t* A; const bf16_t* Bt; int M, N, K; };

struct StaticOrder {
    int nM, nN, nwg, G, c;
    __host__ __device__ void init(int M, int N, int G_, int c_) { nM = M / BM; nN = N / BM; nwg = nM * nN; G = G_; c = c_; }
    __host__ __device__ bool next(int i, Unit& u) const {
        const long L = (long)i * G + c; if (L >= nwg) return false;
        int wgid = (int)L; { const int q = nwg / NXCD, r = nwg % NXCD, xcd = wgid % NXCD, off = wgid / NXCD; wgid = (xcd < r ? xcd * (q + 1) : r * (q + 1) + (xcd - r) * q) + off; }
        const int nig = WGM * nN, gid = wgid / nig, fm = gid * WGM, gsz = (nM - fm) < WGM ? (nM - fm) : WGM;
        u.pm = fm + ((wgid % nig) % gsz); u.pn = (wgid % nig) / gsz; return true;
    }
    __device__ __forceinline__ void a_ready(const Unit&) const {}
    __device__ __forceinline__ void done(const Unit&) const {}
};

struct SplitOrder {
    StaticOrder base; int G, c, nwg, nshort0, light, heavy; bool split;
    __host__ __device__ void init(int M, int N, int G_, int c_, int n_first) {
        base.init(M, N, 1, 0); G = G_; c = c_; nwg = base.nwg; nshort0 = n_first % G_; light = 1; heavy = 3;
        split = (nshort0 > 0) && (nshort0 * light + (G_ - nshort0) * heavy == nwg);
    }
    __host__ __device__ bool next(int i, Unit& u) const {
        long L;
        if (split) { if (c < nshort0) { if (i >= light) return false; L = (long)c * light + i; } else { if (i >= heavy) return false; L = (long)nshort0 * light + (long)(c - nshort0) * heavy + i; } }
        else L = (long)i * G + c;
        if (L >= nwg) return false;
        return base.next((int)L, u);
    }
    __device__ __forceinline__ void a_ready(const Unit&) const {}
    __device__ __forceinline__ void done(const Unit&) const {}
};

__device__ __forceinline__ unsigned cvt_pk_bf16(float lo, float hi) { unsigned r; asm volatile("v_cvt_pk_bf16_f32 %0, %1, %2" : "=v"(r) : "v"(lo), "v"(hi)); return r; }
typedef unsigned u32x2 __attribute__((ext_vector_type(2)));
template <bool I8> struct EpiZ {
    static constexpr bool PERM = true, AFTER_DRAIN = false;
    bf16_t* Z; const float* rope; float* out; int layer; const float* hs; const float* wsc;
    __device__ __forceinline__ void operator()(const f32x4 (&acc)[2][2][4][2], const Unit& u, int wr, int wc, int fr, int fq) const {
        const int pn = I8 ? map8(u.pn) : map16(u.pn), b = u.pm >> 3, rbase = u.pm * BM + wr * 64 + fr, cl = wc * 32 + 8 * fq;
        f32x4 cs[2][2];
        if (I8) {
#pragma unroll
            for (int bj = 0; bj < 2; ++bj)
#pragma unroll
                for (int n = 0; n < 2; ++n) cs[bj][n] = *(const f32x4*)(wsc + u.pn * BM + bj * HALF + cl + 4 * n);
        }
        const int type = pn < 4 ? 0 : pn < 10 ? 1 : pn < 16 ? 2 : pn < 22 ? 3 : pn < 24 ? 4 : pn < 26 ? 5 : 6;
#pragma unroll
        for (int ai = 0; ai < 2; ++ai)
#pragma unroll
            for (int m = 0; m < 4; ++m) {
                const int r = rbase + ai * HALF + m * 16, t = r & 2047;
                bf16_t* zrow = Z + (size_t)r * DIN;
                float rs = 1.0f; if (I8) rs = hs[r];
#pragma unroll
                for (int bj = 0; bj < 2; ++bj) {
                    f32x4 v0 = acc[ai][bj][m][0], v1 = acc[ai][bj][m][1];
                    if (I8) { const i32x4_t a0 = __builtin_bit_cast(i32x4_t, v0), a1 = __builtin_bit_cast(i32x4_t, v1);
#pragma unroll
                        for (int i = 0; i < 4; ++i) { v0[i] = (float)a0[i] * (rs * cs[bj][0][i]); v1[i] = (float)a1[i] * (rs * cs[bj][1][i]); } }
                    const int cpos = pn * BM + bj * HALF;
                    if (type == 0) {
                        const int ch = ((cpos + cl) >> 3) * 4;
                        f32x4 uu;
#pragma unroll
                        for (int i = 0; i < 4; ++i) uu[i] = v0[i] / (1.0f + __expf(-v1[i]));
                        u32x2 w; w.x = cvt_pk_bf16(uu[0], uu[1]); w.y = cvt_pk_bf16(uu[2], uu[3]);
                        *(u32x2*)(zrow + ch) = w;
                        if (t >= SEQ - 30) *(f32x4*)(out + O_CP + ((size_t)((layer * NB + b) * 30 + t - (SEQ - 30))) * WA + ch) = uu;
                    } else if (type == 1 || type == 2 || type == 4 || type == 5) {
                        const int i0 = 16 * wc + 4 * fq;
                        const f32x4 cs0 = *(const f32x4*)(rope + ((size_t)t * 64 + i0) * 2), cs1 = *(const f32x4*)(rope + ((size_t)t * 64 + i0) * 2 + 4);
                        const f32x4 c = (f32x4){cs0[0], cs0[2], cs1[0], cs1[2]}, s = (f32x4){cs0[1], cs0[3], cs1[1], cs1[3]};
                        f32x4 o1 = v0 * c - v1 * s, o2 = v1 * c + v0 * s;
                        float sc = 1.0f;
                        if (type == 1) sc = SQ_ATT;
                        if (type == 4) { const int h = (cpos - OFF_QC) >> 7; sc = __builtin_amdgcn_exp2f((float)(t & 127) * lg2_gamma(h)); }
                        if (type == 5) { const int h = (cpos - OFF_KC) >> 7; sc = KS_RET * __builtin_amdgcn_exp2f(-(float)(t & 127) * lg2_gamma(h)); }
                        o1 = o1 * sc; o2 = o2 * sc;
                        u32x2 w; w.x = cvt_pk_bf16(o1[0], o1[1]); w.y = cvt_pk_bf16(o1[2], o1[3]);
                        *(u32x2*)(zrow + cpos + i0) = w;
                        w.x = cvt_pk_bf16(o2[0], o2[1]); w.y = cvt_pk_bf16(o2[2], o2[3]);
                        *(u32x2*)(zrow + cpos + 64 + i0) = w;
                        if (type == 2) {
                            const int g = (cpos - OFF_KB) >> 9, hh = ((cpos - OFF_KB) >> 7) & 3, L = 128 << (2 * g);
                            const size_t wb = (g == 0 ? O_W1P : g == 1 ? O_W2P : O_W3P);
                            if (t >= SEQ - L) { float* o = out + wb + ((size_t)((layer * NB + b) * L + t - (SEQ - L)) * 2 + 0) * 512 + hh * 128 + i0; *(f32x4*)o = o1; *(f32x4*)(o + 64) = o2; }
                        }
                    } else {
                        u32x4 w; w.x = cvt_pk_bf16(v0[0], v0[1]); w.y = cvt_pk_bf16(v0[2], v0[3]); w.z = cvt_pk_bf16(v1[0], v1[1]); w.w = cvt_pk_bf16(v1[2], v1[3]);
                        *(u32x4*)(zrow + cpos + cl) = w;
                        if (type == 3) {
                            const int g = (cpos - OFF_VB) >> 9, hh = ((cpos - OFF_VB) >> 7) & 3, L = 128 << (2 * g);
                            const size_t wb = (g == 0 ? O_W1P : g == 1 ? O_W2P : O_W3P);
                            if (t >= SEQ - L) { float* o = out + wb + ((size_t)((layer * NB + b) * L + t - (SEQ - L)) * 2 + 1) * 512 + hh * 128 + cl; *(f32x4*)o = v0; *(f32x4*)(o + 4) = v1; }
                        }
                    }
                }
            }
    }
};
struct EpiRes {
    static constexpr bool PERM = false, AFTER_DRAIN = false;
    const float* xsrc; float* X; const float* gate; float wscale;
    __device__ __forceinline__ void operator()(const f32x4 (&acc)[2][2][4][2], const Unit& u, int wr, int wc, int fr, int fq) const {
        const int b = u.pm >> 3, col0 = u.pn * BM + wc * 32 + 4 * fq, row0 = u.pm * BM + wr * 64 + fr;
        f32x4 gv[2][2];
#pragma unroll
        for (int bj = 0; bj < 2; ++bj)
#pragma unroll
            for (int n = 0; n < 2; ++n) gv[bj][n] = *(const f32x4*)(gate + (size_t)b * 12288 + col0 + bj * HALF + n * 16) * wscale;
#pragma unroll
        for (int ai = 0; ai < 2; ++ai)
#pragma unroll
            for (int m = 0; m < 4; ++m) { const size_t off = (size_t)(row0 + ai * HALF + m * 16) * DM + col0;
#pragma unroll
                for (int bj = 0; bj < 2; ++bj)
#pragma unroll
                    for (int n = 0; n < 2; ++n) { const f32x4 xs = *(const f32x4*)(xsrc + off + bj * HALF + n * 16);
                        *(f32x4*)(X + off + bj * HALF + n * 16) = xs * ALPHA + gv[bj][n] * acc[ai][bj][m][n]; } }
    }
};
__device__ __forceinline__ unsigned e4m3x2(float a, float b) { return (unsigned)__builtin_amdgcn_cvt_pk_fp8_f32(fminf(a, 448.f), fminf(b, 448.f), 0, false) & 0xffffu; }
struct EpiUp {
    static constexpr bool PERM = true, AFTER_DRAIN = false;
    unsigned char* O; const float* hs; const float* wsc;
    __device__ __forceinline__ void operator()(const f32x4 (&acc)[2][2][4][2], const Unit& u, int wr, int wc, int fr, int fq) const {
        const int row0 = u.pm * BM + wr * 64 + fr, col0 = u.pn * BM + wc * 32 + 8 * fq;
        f32x4 cs[2][2];
#pragma unroll
        for (int bj = 0; bj < 2; ++bj)
#pragma unroll
            for (int n = 0; n < 2; ++n) cs[bj][n] = *(const f32x4*)(wsc + col0 + bj * HALF + 4 * n);
#pragma unroll
        for (int ai = 0; ai < 2; ++ai)
#pragma unroll
            for (int m = 0; m < 4; ++m) { const int r = row0 + ai * HALF + m * 16; unsigned char* rowp = O + (size_t)r * DFF + col0; const float rs = hs[r];
#pragma unroll
                for (int bj = 0; bj < 2; ++bj) { const i32x4_t a0 = __builtin_bit_cast(i32x4_t, acc[ai][bj][m][0]), a1 = __builtin_bit_cast(i32x4_t, acc[ai][bj][m][1]); f32x4 v0, v1;
#pragma unroll
                    for (int i = 0; i < 4; ++i) { const float a = fmaxf((float)a0[i] * (rs * cs[bj][0][i]), 0.f), c = fmaxf((float)a1[i] * (rs * cs[bj][1][i]), 0.f); v0[i] = a * a; v1[i] = c * c; }
                    u32x2 w; w.x = e4m3x2(v0[0], v0[1]) | (e4m3x2(v0[2], v0[3]) << 16); w.y = e4m3x2(v1[0], v1[1]) | (e4m3x2(v1[2], v1[3]) << 16);
                    *(u32x2*)(rowp + bj * HALF) = w; } }
    }
};
template <class Epi, class Sched, bool ALIGN_EPI = false, bool SP2 = false, int OPK = 0>
__device__ __forceinline__ void gemm_phase(PG8_LAS unsigned char* lds, const Gemm g, const Sched& S, const Epi& E) {
    constexpr bool FP8 = (OPK == 1), I8 = (OPK == 2);
    int tid_op = (int)threadIdx.x; asm volatile("" : "+v"(tid_op));
    const int tid = tid_op, wid = __builtin_amdgcn_readfirstlane(tid >> 6), lane = tid & 63, wr = wid >> 2, wc = wid & 3, fr = lane & 15, fq = lane >> 4;
    const int K = g.K, nt = K / BK;
    unsigned voffA[2], voffB[2];
#pragma unroll
    for (int i = 0; i < 2; ++i) { int R, C; stage_rc(tid * 16 + i * 8192, R, C); const int Rb = Epi::PERM ? ((R & ~31) + perm32(R & 31)) : R;
        voffA[i] = (unsigned)(R * K + C) * 2u; voffB[i] = (unsigned)(Rb * K + C) * 2u; }
    const size_t kstep = (size_t)(BK * 2);
    const size_t hstep = (size_t)HALF * K * 2;
    const size_t tstep = 2 * hstep;
    const unsigned ldsw = (unsigned)wid * 1024u;
    const int aoff = lds_byte(wr * 64 + fr, fq * 8), boff = lds_byte(wc * 32 + fr, fq * 8);
#define PG8_SA(b, h) (((b) * 2 + (h)) * HTB)
#define PG8_SB(b, h) ((4 + (b) * 2 + (h)) * HTB)
#define PG8_STAGE(bufoff, gbase, voff) do { _Pragma("unroll") for (int _i = 0; _i < 2; ++_i) \
        __builtin_amdgcn_global_load_lds((const unsigned*)((const char*)(gbase) + (voff)[_i]), (PG8_LAS unsigned*)(lds + (bufoff) + ldsw + _i * 8192), 16, 0, 0); } while (0)
#define PG8_LDA(dst, b, h) do { _Pragma("unroll") for (int m = 0; m < 4; ++m) _Pragma("unroll") for (int k = 0; k < 2; ++k) dst[m][k] = *(const PG8_LAS bf16x8*)(lds + PG8_SA(b, h) + aoff + m * 2048 + k * 1024); } while (0)
#define PG8_LDB(dst, b, h) do { _Pragma("unroll") for (int n = 0; n < 2; ++n) _Pragma("unroll") for (int k = 0; k < 2; ++k) dst[n][k] = *(const PG8_LAS bf16x8*)(lds + PG8_SB(b, h) + boff + n * 2048 + k * 1024); } while (0)
#define PG8_CAT8(x0, x1) __builtin_shufflevector(__builtin_bit_cast(i32x4_t, x0), __builtin_bit_cast(i32x4_t, x1), 0, 1, 2, 3, 4, 5, 6, 7)
#define PG8_MMA(ai, bj, At, Bt) do { __builtin_amdgcn_s_setprio(1); \
        if constexpr (FP8) { _Pragma("unroll") for (int m = 0; m < 4; ++m) _Pragma("unroll") for (int n = 0; n < 2; ++n) \
            asm volatile("v_mfma_scale_f32_16x16x128_f8f6f4 %0, %1, %2, %0, %3, %3 op_sel_hi:[0,0,0]" : "+v"(acc[ai][bj][m][n]) : "v"(PG8_CAT8(Bt[n][0], Bt[n][1])), "v"(PG8_CAT8(At[m][0], At[m][1])), "v"(fp8_unit_scale)); } \
        else if constexpr (I8) { _Pragma("unroll") for (int m = 0; m < 4; ++m) _Pragma("unroll") for (int n = 0; n < 2; ++n) _Pragma("unroll") for (int k = 0; k < 2; ++k) \
            acc[ai][bj][m][n] = __builtin_bit_cast(f32x4, __builtin_amdgcn_mfma_i32_16x16x64_i8(__builtin_bit_cast(i32x4_t, Bt[n][k]), __builtin_bit_cast(i32x4_t, At[m][k]), __builtin_bit_cast(i32x4_t, acc[ai][bj][m][n]), 0, 0, 0)); } \
        else { _Pragma("unroll") for (int m = 0; m < 4; ++m) _Pragma("unroll") for (int n = 0; n < 2; ++n) _Pragma("unroll") for (int k = 0; k < 2; ++k) \
            acc[ai][bj][m][n] = __builtin_amdgcn_mfma_f32_16x16x32_bf16(Bt[n][k], At[m][k], acc[ai][bj][m][n], 0, 0, 0); } __builtin_amdgcn_s_setprio(0); } while (0)
#define PG8_WAIT_V(n) asm volatile("s_waitcnt vmcnt(" #n ")" ::: "memory")
#define PG8_WAIT_L(n) asm volatile("s_waitcnt lgkmcnt(" #n ")" ::: "memory")
#define PG8_BAR __builtin_amdgcn_s_barrier()
#define PG8_SCHED __builtin_amdgcn_sched_barrier(0)
    Unit cur, nxt; int ui = 0;
    if (!S.next(0, cur)) return;
    f32x4 acc[2][2][4][2];
#pragma unroll
    for (int a = 0; a < 2; ++a)
#pragma unroll
        for (int b = 0; b < 2; ++b)
#pragma unroll
            for (int m = 0; m < 4; ++m)
#pragma unroll
                for (int n = 0; n < 2; ++n) acc[a][b][m][n] = (f32x4){0.f, 0.f, 0.f, 0.f};
    bf16x8 At[4][2], B0[2][2], B1[2][2];
    const int fp8_unit_scale = 0x7f7f7f7f; (void)fp8_unit_scale;
    const char* cA = (const char*)g.A + (size_t)cur.pm * tstep; const char* cB = (const char*)g.Bt + (size_t)cur.pn * tstep;
    S.a_ready(cur);
    if constexpr (SP2) {
        PG8_STAGE(PG8_SB(0, 0), cB, voffB); PG8_STAGE(PG8_SB(0, 1), cB + hstep, voffB); PG8_STAGE(PG8_SA(0, 0), cA, voffA); PG8_STAGE(PG8_SA(0, 1), cA + hstep, voffA);
        if (wr == 1) PG8_BAR;
        PG8_WAIT_V(2); PG8_BAR;
        PG8_STAGE(PG8_SB(1, 0), cB + kstep, voffB); PG8_STAGE(PG8_SA(1, 0), cA + kstep, voffA); PG8_STAGE(PG8_SB(1, 1), cB + hstep + kstep, voffB);
        PG8_WAIT_V(6); PG8_BAR;
    } else {
        PG8_STAGE(PG8_SB(0, 0), cB, voffB); PG8_STAGE(PG8_SA(0, 0), cA, voffA); PG8_STAGE(PG8_SB(0, 1), cB + hstep, voffB); PG8_STAGE(PG8_SA(0, 1), cA + hstep, voffA);
        if (wr == 1) PG8_BAR;
        PG8_WAIT_V(4); PG8_BAR;
        PG8_STAGE(PG8_SB(1, 0), cB + kstep, voffB); PG8_STAGE(PG8_SA(1, 0), cA + kstep, voffA); PG8_STAGE(PG8_SB(1, 1), cB + hstep + kstep, voffB);
        PG8_WAIT_V(6); PG8_BAR;
    }
    for (;;) {
        const bool has_next = S.next(ui + 1, nxt);
        const char* nA = has_next ? (const char*)g.A + (size_t)nxt.pm * tstep : cA; const char* nB = has_next ? (const char*)g.Bt + (size_t)nxt.pn * tstep : cB;
        for (int t = 0; t < nt; t += 2) {
            const bool last = (t == nt - 2);
            const char* a1 = cA + (size_t)(t + 1) * kstep;
            const char* a2 = last ? nA : cA + (size_t)(t + 2) * kstep; const char* b2 = last ? nB : cB + (size_t)(t + 2) * kstep;
            const char* a3 = a2 + kstep; const char* b3 = b2 + kstep;
            if (last && has_next) S.a_ready(nxt);
            if constexpr (SP2) {
            PG8_LDB(B0, 0, 0); PG8_LDB(B1, 0, 1); PG8_SCHED; PG8_LDA(At, 0, 0); PG8_STAGE(PG8_SA(1, 1), a1 + hstep, voffA);
            PG8_WAIT_V(8); PG8_WAIT_L(0); PG8_BAR; PG8_MMA(0, 0, At, B0); PG8_MMA(0, 1, At, B1); PG8_BAR; PG8_SCHED;
            PG8_LDA(At, 0, 1); PG8_STAGE(PG8_SB(0, 0), b2, voffB); PG8_STAGE(PG8_SB(0, 1), b2 + hstep, voffB); PG8_STAGE(PG8_SA(0, 0), a2, voffA);
            PG8_WAIT_V(8); PG8_WAIT_L(0); PG8_BAR; PG8_MMA(1, 0, At, B0); PG8_MMA(1, 1, At, B1); PG8_BAR; PG8_SCHED;
            PG8_LDB(B0, 1, 0); PG8_LDB(B1, 1, 1); PG8_SCHED; PG8_LDA(At, 1, 0); PG8_STAGE(PG8_SA(0, 1), a2 + hstep, voffA);
            PG8_WAIT_V(8); PG8_WAIT_L(0); PG8_BAR; PG8_MMA(0, 0, At, B0); PG8_MMA(0, 1, At, B1); PG8_BAR; PG8_SCHED;
            PG8_LDA(At, 1, 1); PG8_STAGE(PG8_SB(1, 0), b3, voffB); PG8_STAGE(PG8_SB(1, 1), b3 + hstep, voffB); PG8_STAGE(PG8_SA(1, 0), a3, voffA);
            PG8_WAIT_V(8); PG8_WAIT_L(0); PG8_BAR; PG8_MMA(1, 0, At, B0); PG8_MMA(1, 1, At, B1); PG8_BAR; PG8_SCHED;
            } else {
            PG8_LDB(B0, 0, 0); PG8_SCHED; PG8_LDA(At, 0, 0); PG8_STAGE(PG8_SA(1, 1), a1 + hstep, voffA);
            PG8_WAIT_L(8); PG8_BAR; PG8_WAIT_L(0); PG8_MMA(0, 0, At, B0); PG8_BAR; PG8_SCHED;
            PG8_LDB(B1, 0, 1); PG8_STAGE(PG8_SB(0, 0), b2, voffB);
            PG8_BAR; PG8_WAIT_L(0); PG8_MMA(0, 1, At, B1); PG8_BAR;
            PG8_LDA(At, 0, 1); PG8_STAGE(PG8_SA(0, 0), a2, voffA);
            PG8_BAR; PG8_WAIT_L(0); PG8_MMA(1, 0, At, B0); PG8_BAR; PG8_SCHED;
            PG8_STAGE(PG8_SB(0, 1), b2 + hstep, voffB);
            PG8_WAIT_V(6); PG8_BAR; PG8_MMA(1, 1, At, B1); PG8_BAR;
            PG8_LDB(B0, 1, 0); PG8_SCHED; PG8_LDA(At, 1, 0); PG8_STAGE(PG8_SA(0, 1), a2 + hstep, voffA);
            PG8_WAIT_L(8); PG8_BAR; PG8_WAIT_L(0); PG8_MMA(0, 0, At, B0); PG8_BAR; PG8_SCHED;
            PG8_LDB(B1, 1, 1); PG8_STAGE(PG8_SB(1, 0), b3, voffB);
            PG8_BAR; PG8_WAIT_L(0); PG8_MMA(0, 1, At, B1); PG8_BAR;
            PG8_LDA(At, 1, 1); PG8_STAGE(PG8_SA(1, 0), a3, voffA);
            PG8_BAR; PG8_WAIT_L(0); PG8_MMA(1, 0, At, B0); PG8_BAR; PG8_SCHED;
            PG8_STAGE(PG8_SB(1, 1), b3 + hstep, voffB);
            PG8_WAIT_V(6); PG8_BAR; PG8_MMA(1, 1, At, B1); PG8_BAR;
            }
        }
        if constexpr (FP8) { asm volatile("s_nop 15\n\ts_nop 15" ::: "memory"); }
        if constexpr (ALIGN_EPI) { if (wr == 0) PG8_BAR; }
        if constexpr (!Epi::AFTER_DRAIN) { E(acc, cur, wr, wc, fr, fq); S.done(cur); }
        if (!has_next) break;
#pragma unroll
        for (int a = 0; a < 2; ++a)
#pragma unroll
            for (int b = 0; b < 2; ++b)
#pragma unroll
                for (int m = 0; m < 4; ++m)
#pragma unroll
                    for (int n = 0; n < 2; ++n) acc[a][b][m][n] = (f32x4){0.f, 0.f, 0.f, 0.f};
        cur = nxt; cA = nA; cB = nB; ++ui;
        if constexpr (ALIGN_EPI) { if (wr == 1) PG8_BAR; }
    }
    PG8_WAIT_V(0);
    if constexpr (!ALIGN_EPI) { if (wr == 0) PG8_BAR; }
    PG8_BAR;
    if constexpr (Epi::AFTER_DRAIN) { E.fused(acc, cur, wr, wc, fr, fq, lds, wid, lane); S.done(cur); }
#undef PG8_SA
#undef PG8_SB
#undef PG8_STAGE
#undef PG8_LDA
#undef PG8_LDB
#undef PG8_MMA
#undef PG8_CAT8
#undef PG8_WAIT_V
#undef PG8_WAIT_L
#undef PG8_BAR
#undef PG8_SCHED
}
}
#define GAS __attribute__((address_space(1)))
#define LAS __attribute__((address_space(3)))
typedef unsigned short bf16;
typedef unsigned v4u __attribute__((ext_vector_type(4)));
typedef unsigned v2u __attribute__((ext_vector_type(2)));
typedef float f32x4 __attribute__((ext_vector_type(4)));
typedef float f32x2 __attribute__((ext_vector_type(2)));
typedef short bf16x8 __attribute__((ext_vector_type(8)));
typedef short s16x4 __attribute__((ext_vector_type(4)));
typedef GAS unsigned gu32;
#define RLX_AGENT __ATOMIC_RELAXED, __HIP_MEMORY_SCOPE_AGENT
#define LDS_WAIT() asm volatile("s_waitcnt lgkmcnt(0)" ::: "memory")
#define VM_WAIT() asm volatile("s_waitcnt vmcnt(0)" ::: "memory")
__device__ __forceinline__ unsigned f2bf(float f) { unsigned u = __builtin_bit_cast(unsigned, f); return (u + 0x7fffu + ((u >> 16) & 1u)) >> 16; }
__device__ __forceinline__ unsigned pk2(float lo, float hi) { return f2bf(lo) | (f2bf(hi) << 16); }
__device__ __forceinline__ float bf2f(unsigned short v) { return __builtin_bit_cast(float, (unsigned)v << 16); }
__device__ __forceinline__ float bflo(unsigned w) { return __builtin_bit_cast(float, w << 16); }
__device__ __forceinline__ float bfhi(unsigned w) { return __builtin_bit_cast(float, w & 0xffff0000u); }
__device__ __forceinline__ float wave_sum(float v) {
#pragma unroll
    for (int o = 1; o < 64; o <<= 1) v += __shfl_xor(v, o);
    return v;
}
__device__ __forceinline__ float wave_max(float v) {
#pragma unroll
    for (int o = 1; o < 64; o <<= 1) v = fmaxf(v, __shfl_xor(v, o));
    return v;
}
__device__ __forceinline__ float silu_f(float v) { return v / (1.0f + __expf(-v)); }
__device__ __forceinline__ float sigm_f(float v) { return 1.0f / (1.0f + __expf(-v)); }
__device__ __forceinline__ bf16x8 tr8(LAS const unsigned char* img, int pitch, int r0a, int r0b, int c0, int lane) {
    const int q = (lane & 15) >> 2, p = lane & 3;
    const s16x4 lo = __builtin_bit_cast(s16x4, __builtin_amdgcn_ds_read_tr16_b64_v4i16((LAS s16x4*)(img + (r0a + q) * pitch + (c0 + 4 * p) * 2)));
    const s16x4 hi = __builtin_bit_cast(s16x4, __builtin_amdgcn_ds_read_tr16_b64_v4i16((LAS s16x4*)(img + (r0b + q) * pitch + (c0 + 4 * p) * 2)));
    return (bf16x8){lo[0], lo[1], lo[2], lo[3], hi[0], hi[1], hi[2], hi[3]};
}
__device__ __forceinline__ bf16x8 pack8(f32x4 a, f32x4 b) {
    v4u w; w.x = pk2(a[0], a[1]); w.y = pk2(a[2], a[3]); w.z = pk2(b[0], b[1]); w.w = pk2(b[2], b[3]);
    return __builtin_bit_cast(bf16x8, w);
}
#define MFMA16(a, b, c) __builtin_amdgcn_mfma_f32_16x16x32_bf16((a), (b), (c), 0, 0, 0)
__host__ __device__ __forceinline__ int perm_in(int n) {
    if (n < 1024) { const int q = n >> 3, s = n & 7; return s < 4 ? 4 * q + s : 512 + 4 * q + (s - 4); }
    if ((n >= OFF_QB && n < OFF_VB) || (n >= OFF_QC && n < OFF_VC)) { const int hb = n & ~127, p = n & 127, q = p >> 3, s = p & 7; return hb + (s < 4 ? 4 * q + s : 64 + 4 * q + (s - 4)); }
    return n;
}
__device__ __forceinline__ unsigned fp8x2(float a, float b) {
    a = fminf(fmaxf(a, -448.f), 448.f); b = fminf(fmaxf(b, -448.f), 448.f);
    return (unsigned)__builtin_amdgcn_cvt_pk_fp8_f32(a, b, 0, false) & 0xffffu;
}
typedef int v8i_t __attribute__((ext_vector_type(8)));
typedef int v4i_t __attribute__((ext_vector_type(4)));
#define MFMA8(a, b, c) __builtin_amdgcn_mfma_scale_f32_16x16x128_f8f6f4((a), (b), (c), 0, 0, 0, 0x7f7f7f7f, 0, 0x7f7f7f7f)
constexpr float WDN_SCALE = 1024.0f;
__device__ __forceinline__ unsigned q8x4(float a, float b, float c, float d, float inv) {
    const int ia = (int)fminf(fmaxf(rintf(a * inv), -127.f), 127.f), ib = (int)fminf(fmaxf(rintf(b * inv), -127.f), 127.f), ic = (int)fminf(fmaxf(rintf(c * inv), -127.f), 127.f), id = (int)fminf(fmaxf(rintf(d * inv), -127.f), 127.f);
    return (unsigned)(ia & 0xff) | ((unsigned)(ib & 0xff) << 8) | ((unsigned)(ic & 0xff) << 16) | ((unsigned)(id & 0xff) << 24);
}
#define MFMAI8(a, b, c) __builtin_amdgcn_mfma_i32_16x16x64_i8((a), (b), (c), 0, 0, 0)
#define XB_TMO      128
#define XB_XCNT(j)  (256  + 64 * (j))
#define XB_XSUB(j)  (1280 + 64 * (j))
#define XB_XGEN(j)  (2304 + 64 * (j))
#define XB_TOP      3328
#define XB_TOPGEN   3392
#define XCD_BAR_WORDS 3456
#define XB_SPIN_CAP (1u << 18)

__device__ __forceinline__ unsigned xb_ld(unsigned* p)              { return __hip_atomic_load(p, __ATOMIC_RELAXED, __HIP_MEMORY_SCOPE_AGENT); }
__device__ __forceinline__ unsigned xb_add(unsigned* p, unsigned v) { return __hip_atomic_fetch_add(p, v, __ATOMIC_RELAXED, __HIP_MEMORY_SCOPE_AGENT); }
__device__ __forceinline__ unsigned xb_xcc_id() { return (unsigned)__builtin_amdgcn_s_getreg((3 << 11) | 20) & 0xFu; }
#define XB_SPIN(cond, bar) do { unsigned _sp = 0; while (cond) { __builtin_amdgcn_s_sleep(1); \
    if ((++_sp & 255u) == 0u) { if (xb_ld(&(bar)[XB_TMO])) break; if (_sp > XB_SPIN_CAP) { atomicAdd(&(bar)[XB_TMO], 1u); break; } } } } while (0)

struct XcdBarrier {
    unsigned* bar; unsigned x;
    volatile LAS unsigned* st;
};

__device__ __forceinline__ XcdBarrier xcd_barrier_post(unsigned* bar, volatile LAS unsigned* st) {
    XcdBarrier b; b.bar = bar; b.x = xb_xcc_id(); b.st = st;
    if (threadIdx.x == 0) (void)xb_add(&bar[XB_XCNT(b.x)], 1u);
    return b;
}
__device__ __forceinline__ void xcd_barrier_complete(unsigned* bar, unsigned x, unsigned& nloc, unsigned& nx) {
    const unsigned G = gridDim.x * gridDim.y * gridDim.z;
    unsigned sum, cnt, mine, sp = 0u;
    for (;;) {
        sum = 0u; cnt = 0u; mine = 0u;
#pragma unroll
        for (unsigned j = 0; j < 16; ++j) { const unsigned c = xb_ld(&bar[XB_XCNT(j)]); sum += c; cnt += (c > 0u) ? 1u : 0u; mine = (j == x) ? c : mine; }
        if (sum == G) break;
        __builtin_amdgcn_s_sleep(1);
        if ((++sp & 255u) == 0u) { if (xb_ld(&bar[XB_TMO])) break; if (sp > XB_SPIN_CAP) { atomicAdd(&bar[XB_TMO], 1u); break; } }
    }
    nloc = mine > 0u ? mine : 1u; nx = cnt > 0u ? cnt : 1u;
}

__device__ __forceinline__ void xcd_barrier(const XcdBarrier& b) {
    asm volatile("s_waitcnt vmcnt(0)" ::: "memory");
    __syncthreads();
    if (threadIdx.x == 0) {
        unsigned* bar = b.bar;
        __builtin_amdgcn_s_waitcnt(0);
        unsigned nloc = b.st[0], nx = b.st[1];
        if (nloc == 0u) { xcd_barrier_complete(bar, b.x, nloc, nx); b.st[0] = nloc; b.st[1] = nx; }
        const unsigned old = xb_add(&bar[XB_XSUB(b.x)], 1u);
        const unsigned gen = old / nloc;
        if (old + 1u == (gen + 1u) * nloc) {
            __builtin_amdgcn_fence(__ATOMIC_RELEASE, "agent");
            asm volatile("s_waitcnt vmcnt(0)" ::: "memory");
            const unsigned og = xb_add(&bar[XB_TOP], 1u);
            const unsigned tg = og / nx;
            if (og + 1u == (tg + 1u) * nx) xb_add(&bar[XB_TOPGEN], 1u);
            else XB_SPIN(xb_ld(&bar[XB_TOPGEN]) == tg, bar);
            __builtin_amdgcn_fence(__ATOMIC_ACQUIRE, "agent");
            xb_add(&bar[XB_XGEN(b.x)], 1u);
            asm volatile("s_waitcnt vmcnt(0)" ::: "memory");
        } else {
            XB_SPIN(xb_ld(&bar[XB_XGEN(b.x)]) == gen, bar);
            __builtin_amdgcn_fence(__ATOMIC_ACQUIRE, "agent");
            asm volatile("s_waitcnt vmcnt(0)" ::: "memory");
        }
    }
    __syncthreads();
}
struct Ctx { LAS unsigned char* lds; int wave, bid, G; };
#define TID tid_
#define LANE lane_
__device__ __forceinline__ int opaque_tid() { int t = (int)threadIdx.x; asm volatile("" : "+v"(t)); return t; }
#define DECL_TID const int tid_ = opaque_tid(); const int lane_ = tid_ & 63; (void)lane_;

__device__ __forceinline__ void phase_mod(const Ctx& C, const float* cP, const float* cS, const float* w_ada, const float* b_ada, float* mod, float* rope, const float* w_up, float* wsc, const float* w_in, float* wsci) {
    DECL_TID
    {
        LAS float* redm = (LAS float*)(C.lds + 98304);
        for (int u = C.bid; u < DEPTH * 64; u += C.G) {
            const int l = u >> 6, n0 = (u & 63) * 128;
            const float* wp = w_up + ((size_t)l * DM + C.wave * 256) * DFF + n0 + 2 * LANE;
            float m0 = 0.f, m1 = 0.f;
#pragma unroll 16
            for (int k = 0; k < 256; ++k) { const f32x2 w = *(const f32x2*)(wp + (size_t)k * DFF); m0 = fmaxf(m0, fabsf(w[0])); m1 = fmaxf(m1, fabsf(w[1])); }
            redm[C.wave * 128 + 2 * LANE] = m0; redm[C.wave * 128 + 2 * LANE + 1] = m1;
            __syncthreads();
            if (TID < 128) { float m = 0.f;
#pragma unroll
                for (int w = 0; w < 8; ++w) m = fmaxf(m, redm[w * 128 + TID]);
                wsc[l * DFF + n0 + TID] = m * (1.0f / 127.0f); }
            __syncthreads();
        }
        for (int u = C.bid; u < DEPTH * (NIN8 / 128); u += C.G) {
            const int l = u / (NIN8 / 128), n0 = (u % (NIN8 / 128)) * 128;
            const float* wp = w_in + ((size_t)l * DM + C.wave * 256) * DIN + perm_in(pos8(n0 + 2 * LANE));
            float m0 = 0.f, m1 = 0.f;
#pragma unroll 16
            for (int k = 0; k < 256; ++k) { const f32x2 w = *(const f32x2*)(wp + (size_t)k * DIN); m0 = fmaxf(m0, fabsf(w[0])); m1 = fmaxf(m1, fabsf(w[1])); }
            redm[C.wave * 128 + 2 * LANE] = m0; redm[C.wave * 128 + 2 * LANE + 1] = m1;
            __syncthreads();
            if (TID < 128) { float m = 0.f;
#pragma unroll
                for (int w = 0; w < 8; ++w) m = fmaxf(m, redm[w * 128 + TID]);
                wsci[l * NIN8 + n0 + TID] = m * (1.0f / 127.0f); }
            __syncthreads();
        }
    }
    for (int i = C.bid * NTHR + TID; i < 2052 * 64; i += C.G * NTHR) {
        const int p = i >> 6, f = i & 63;
        const double inv = exp2(-(double)f * (13.287712379549449 / 64.0));
        const double ang = (double)(p < 2048 ? p : PAST + p - 2048) * inv;
        double s, c; sincos(ang, &s, &c);
        rope[2 * i] = (float)c; rope[2 * i + 1] = (float)s;
    }
    LAS float* scs = (LAS float*)C.lds;
    LAS float* red = (LAS float*)(C.lds + 98304);
    for (int i = TID; i < 12 * 2048; i += NTHR) { const int r = i >> 11, k = i & 2047; const float v = r < 4 ? cP[r * 2048 + k] : cS[(r - 4) * 2048 + k]; scs[i] = silu_f(v); }
    __syncthreads();
    for (int u = C.bid; u < DEPTH * 192; u += C.G) {
        const int l = u / 192, n0 = (u % 192) * 64;
        const float* wp = w_ada + ((size_t)l * 2048 + C.wave * 256) * 12288 + n0 + LANE;
        float acc[12];
#pragma unroll
        for (int r = 0; r < 12; ++r) acc[r] = 0.f;
#pragma unroll 4
        for (int k = 0; k < 256; k += 4) {
            const float w0 = wp[(size_t)k * 12288], w1 = wp[(size_t)(k + 1) * 12288], w2 = wp[(size_t)(k + 2) * 12288], w3 = wp[(size_t)(k + 3) * 12288];
#pragma unroll
            for (int r = 0; r < 12; ++r) { const f32x4 s = *(const LAS f32x4*)(scs + r * 2048 + C.wave * 256 + k); acc[r] += (s[0] * w0 + s[1] * w1) + (s[2] * w2 + s[3] * w3); }
        }
#pragma unroll
        for (int r = 0; r < 12; ++r) red[(C.wave * 12 + r) * 64 + LANE] = acc[r];
        __syncthreads();
        for (int i = TID; i < 768; i += NTHR) { const int r = i >> 6, c = i & 63; float s = 0.f;
#pragma unroll
            for (int w = 0; w < 8; ++w) s += red[(w * 12 + r) * 64 + c];
            mod[((size_t)l * 12 + r) * 12288 + n0 + c] = s + b_ada[l * 12288 + n0 + c]; }
        __syncthreads();
    }
}

__device__ __forceinline__ void transpose_item(const float* W, int K, int N, int ldw, bf16* WT, bool perm, LAS float* scr, int item, int lane) {
    const int nblk = N / 32, kb = item / nblk, nb = item % nblk, k0 = 64 * kb, n0 = 32 * nb;
    const int srcc = perm ? perm_in(pos16(n0 + (lane & 31))) : n0 + (lane & 31);
    { float t[32];
#pragma unroll
      for (int i = 0; i < 32; ++i) t[i] = W[(size_t)(k0 + 2 * i + (lane >> 5)) * ldw + srcc];
#pragma unroll
      for (int i = 0; i < 32; ++i) scr[(2 * i + (lane >> 5)) * 33 + (lane & 31)] = t[i]; }
    LDS_WAIT(); asm volatile("" ::: "memory");
    const int c = lane & 7;
#pragma unroll
    for (int j = 0; j < 4; ++j) { const int n = (lane >> 3) + 8 * j; const LAS float* s = scr + (8 * c) * 33 + n;
        v4u o; o.x = pk2(s[0 * 33], s[1 * 33]); o.y = pk2(s[2 * 33], s[3 * 33]); o.z = pk2(s[4 * 33], s[5 * 33]); o.w = pk2(s[6 * 33], s[7 * 33]);
        *(v4u*)(WT + (size_t)(n0 + n) * K + k0 + 8 * c) = o; }
    LDS_WAIT(); asm volatile("" ::: "memory");
}
__device__ __forceinline__ void transpose_item_fp8(const float* W, int K, int N, unsigned char* WT8, float scale, LAS float* scr, int item, int lane) {
    const int nblk = N / 32, kb = item / nblk, nb = item % nblk, k0 = 128 * kb, n0 = 32 * nb;
#pragma unroll
    for (int hh = 0; hh < 2; ++hh) { float t[32];
#pragma unroll
      for (int i = 0; i < 32; ++i) t[i] = W[(size_t)(k0 + 64 * hh + 2 * i + (lane >> 5)) * N + n0 + (lane & 31)];
#pragma unroll
      for (int i = 0; i < 32; ++i) scr[(64 * hh + 2 * i + (lane >> 5)) * 33 + (lane & 31)] = t[i]; }
    LDS_WAIT(); asm volatile("" ::: "memory");
    const int n = lane & 31, kc = lane >> 5; const LAS float* s = scr + (64 * kc) * 33 + n;
    unsigned char* dst = WT8 + (size_t)(n0 + n) * K + k0 + 64 * kc;
#pragma unroll
    for (int j = 0; j < 4; ++j) { v4u o;
        o.x = fp8x2(s[(16 * j + 0) * 33] * scale, s[(16 * j + 1) * 33] * scale) | (fp8x2(s[(16 * j + 2) * 33] * scale, s[(16 * j + 3) * 33] * scale) << 16);
        o.y = fp8x2(s[(16 * j + 4) * 33] * scale, s[(16 * j + 5) * 33] * scale) | (fp8x2(s[(16 * j + 6) * 33] * scale, s[(16 * j + 7) * 33] * scale) << 16);
        o.z = fp8x2(s[(16 * j + 8) * 33] * scale, s[(16 * j + 9) * 33] * scale) | (fp8x2(s[(16 * j + 10) * 33] * scale, s[(16 * j + 11) * 33] * scale) << 16);
        o.w = fp8x2(s[(16 * j + 12) * 33] * scale, s[(16 * j + 13) * 33] * scale) | (fp8x2(s[(16 * j + 14) * 33] * scale, s[(16 * j + 15) * 33] * scale) << 16);
        *(v4u*)(dst + 16 * j) = o; }
    LDS_WAIT(); asm volatile("" ::: "memory");
}
__device__ __forceinline__ void transpose_item_i8(const float* W, int K, int N, int ldw, bool perm, unsigned char* WT8, const float* wsc, LAS float* scr, int item, int lane) {
    const int nblk = N / 32, kb = item / nblk, nb = item % nblk, k0 = 128 * kb, n0 = 32 * nb;
    const int srcc = perm ? perm_in(pos8(n0 + (lane & 31))) : n0 + (lane & 31);
#pragma unroll
    for (int hh = 0; hh < 2; ++hh) { float t[32];
#pragma unroll
      for (int i = 0; i < 32; ++i) t[i] = W[(size_t)(k0 + 64 * hh + 2 * i + (lane >> 5)) * ldw + srcc];
#pragma unroll
      for (int i = 0; i < 32; ++i) scr[(64 * hh + 2 * i + (lane >> 5)) * 33 + (lane & 31)] = t[i]; }
    LDS_WAIT(); asm volatile("" ::: "memory");
    const int n = lane & 31, kc = lane >> 5; const LAS float* s = scr + (64 * kc) * 33 + n;
    const float sc = wsc[n0 + n], inv = sc > 0.f ? 1.0f / sc : 0.f;
    unsigned char* dst = WT8 + (size_t)(n0 + n) * K + k0 + 64 * kc;
#pragma unroll
    for (int j = 0; j < 4; ++j) { v4u o;
        o.x = q8x4(s[(16 * j + 0) * 33], s[(16 * j + 1) * 33], s[(16 * j + 2) * 33], s[(16 * j + 3) * 33], inv);
        o.y = q8x4(s[(16 * j + 4) * 33], s[(16 * j + 5) * 33], s[(16 * j + 6) * 33], s[(16 * j + 7) * 33], inv);
        o.z = q8x4(s[(16 * j + 8) * 33], s[(16 * j + 9) * 33], s[(16 * j + 10) * 33], s[(16 * j + 11) * 33], inv);
        o.w = q8x4(s[(16 * j + 12) * 33], s[(16 * j + 13) * 33], s[(16 * j + 14) * 33], s[(16 * j + 15) * 33], inv);
        *(v4u*)(dst + 16 * j) = o; }
    LDS_WAIT(); asm volatile("" ::: "memory");
}
__device__ __forceinline__ void modulate_row_bf16(const float* xrow, const float* sc, const float* sh, bf16* hrow, int lane) {
#pragma unroll
    for (int j = 0; j < 8; ++j) { const int c = 4 * lane + 256 * j; const f32x4 x = *(const f32x4*)(xrow + c), a = *(const f32x4*)(sc + c), d = *(const f32x4*)(sh + c);
        const f32x4 h = x * (a + 1.0f) + d; v2u w; w.x = pk2(h[0], h[1]); w.y = pk2(h[2], h[3]); *(v2u*)(hrow + c) = w; }
}
__device__ __forceinline__ void phase_prep(const Ctx& C, const float* const* in, float* out, unsigned char* ws) {
    DECL_TID
    LAS float* scr = (LAS float*)(C.lds + C.wave * 17408);
    const int gw = C.bid * NWAVES + C.wave, NGW = C.G * NWAVES;
    constexpr int I_IN = (DM / 64) * (NIN16 / 32), I_IN8 = (DM / 128) * (NIN8 / 32), I_O = (DM / 64) * (DM / 32), I_UP = (DM / 128) * (DFF / 32), I_DN = (DFF / 128) * (DM / 32), I_L = I_IN + I_IN8 + I_O + I_UP + I_DN;
    constexpr int N_CONV = DEPTH * I_L, N_WROW = DEPTH * NBS * (124 + 508 + 2044), N_CROW = DEPTH * NBS * 26, N_ALL = N_CONV + N_WROW + N_CROW + MT;
    const float* mod = (const float*)(ws + WS_MOD);
    for (int it = gw; it < N_ALL; it += NGW) {
        int r = it;
        if (r < N_CONV) {
            const int l = r / I_L; r -= l * I_L;
            if (r < I_IN) { transpose_item(in[11] + (size_t)l * DM * DIN, DM, NIN16, DIN, (bf16*)(ws + WS_WIN) + (size_t)l * NIN16 * DM, true, scr, r, LANE); continue; } r -= I_IN;
            if (r < I_IN8) { transpose_item_i8(in[11] + (size_t)l * DM * DIN, DM, NIN8, DIN, true, ws + WS_WIN8 + (size_t)l * NIN8 * DM, (const float*)(ws + WS_WSCI) + l * NIN8, scr, r, LANE); continue; } r -= I_IN8;
            if (r < I_O) { transpose_item(in[16] + (size_t)l * DM * DM, DM, DM, DM, (bf16*)(ws + WS_WO) + (size_t)l * DM * DM, false, scr, r, LANE); continue; } r -= I_O;
            if (r < I_UP) { transpose_item_i8(in[19] + (size_t)l * DM * DFF, DM, DFF, DFF, false, ws + WS_WUP + (size_t)l * DFF * DM, (const float*)(ws + WS_WSC) + l * DFF, scr, r, LANE); continue; } r -= I_UP;
            transpose_item_fp8(in[20] + (size_t)l * DFF * DM, DFF, DM, ws + WS_WDN + (size_t)l * DM * DFF, WDN_SCALE, scr, r, LANE); continue;
        }
        r -= N_CONV;
        if (r < N_WROW) {
            const int lb = r / 2676, j = r % 2676; int g, row; if (j < 124) { g = 0; row = j; } else if (j < 632) { g = 1; row = j - 124; } else { g = 2; row = j - 632; }
            const int L = 128 << (2 * g);
            const float* src = (g == 0 ? in[3] : g == 1 ? in[4] : in[5]) + ((size_t)lb * L + row + 4) * 1024;
            float* dst = out + (g == 0 ? O_W1S : g == 1 ? O_W2S : O_W3S) + ((size_t)lb * L + row) * 1024;
#pragma unroll
            for (int j4 = 0; j4 < 4; ++j4) *(f32x4*)(dst + 4 * LANE + 256 * j4) = *(const f32x4*)(src + 4 * LANE + 256 * j4);
            continue;
        }
        r -= N_WROW;
        if (r < N_CROW) {
            const int lb = r / 26, row = r % 26;
            const float* src = in[2] + ((size_t)lb * 30 + row + 4) * WA; float* dst = out + O_CS + ((size_t)lb * 30 + row) * WA;
#pragma unroll
            for (int j4 = 0; j4 < 2; ++j4) *(f32x4*)(dst + 4 * LANE + 256 * j4) = *(const f32x4*)(src + 4 * LANE + 256 * j4);
            continue;
        }
        r -= N_CROW;
        {
            const float* xrow = r < MP ? in[0] + (size_t)r * DM : in[1] + (size_t)(r - MP) * DM;
            const int rb = r < MP ? (r >> 11) : 4 + ((r - MP) >> 2);
            const float* mrow = mod + (size_t)rb * 12288;
            f32x4 hv[8];
#pragma unroll
            for (int j = 0; j < 8; ++j) { const int c = 4 * LANE + 256 * j; hv[j] = *(const f32x4*)(xrow + c) * (*(const f32x4*)(mrow + 2048 + c) + 1.0f) + *(const f32x4*)(mrow + c);
                v2u w; w.x = pk2(hv[j][0], hv[j][1]); w.y = pk2(hv[j][2], hv[j][3]); *(v2u*)((bf16*)(ws + WS_H) + (size_t)r * DM + c) = w; }
            float am = 0.f;
#pragma unroll
            for (int j = 0; j < 8; ++j) am = fmaxf(am, fmaxf(fmaxf(fabsf(hv[j][0]), fabsf(hv[j][1])), fmaxf(fabsf(hv[j][2]), fabsf(hv[j][3]))));
            am = wave_max(am);
            const float inv = am > 0.f ? 127.0f / am : 0.f;
#pragma unroll
            for (int j = 0; j < 8; ++j) *(unsigned*)(ws + WS_H8 + (size_t)r * DM + 4 * LANE + 256 * j) = q8x4(hv[j][0], hv[j][1], hv[j][2], hv[j][3], inv);
            if (LANE == 0) ((float*)(ws + WS_HSC))[r] = am * (1.0f / 127.0f);
        }
    }
}

__device__ __forceinline__ void ln_load(int l, int which, const float* const* in, unsigned char* ws, int r, int lane, f32x4 (&v)[8]) {
    const float* X = (const float*)(ws + WS_X); const float* mod = (const float*)(ws + WS_MOD); const float* TSr = (const float*)(ws + WS_TS);
    if (r < MP) {
#pragma unroll
        for (int j = 0; j < 8; ++j) v[j] = *(const f32x4*)(X + (size_t)r * DM + 4 * lane + 256 * j);
    } else {
        const int rb = 4 + ((r - MP) >> 2);
        const float* xs = (l == 0 && which == 1) ? in[1] + (size_t)(r - MP) * DM : X + (size_t)r * DM;
        const float* gt = mod + ((size_t)l * 12 + rb) * 12288 + (which == 1 ? 2 : 5) * 2048; const float* tr = TSr + (size_t)(r - MP) * DM;
#pragma unroll
        for (int j = 0; j < 8; ++j) { const int c = 4 * lane + 256 * j; v[j] = *(const f32x4*)(xs + c) * ALPHA + *(const f32x4*)(gt + c) * *(const f32x4*)(tr + c); }
    }
}
__device__ __forceinline__ void ln_finish(int l, int which, const float* const* in, float* out, unsigned char* ws, bool dummy, int r, int lane, f32x4 (&v)[8]) {
    const float* mod = (const float*)(ws + WS_MOD);
    const float* gam = (which == 1 ? in[17] : in[21]) + (size_t)l * DM; const float* bet = (which == 1 ? in[18] : in[22]) + (size_t)l * DM;
    const bool last = (l == DEPTH - 1 && which == 2);
    const int rb = r < MP ? (r >> 11) : 4 + ((r - MP) >> 2);
    float s = 0.f;
#pragma unroll
    for (int j = 0; j < 8; ++j) s += (v[j][0] + v[j][1]) + (v[j][2] + v[j][3]);
    const float mean = wave_sum(s) * (1.0f / DM); float s2 = 0.f;
#pragma unroll
    for (int j = 0; j < 8; ++j) { v[j] = v[j] - mean; s2 += (v[j][0] * v[j][0] + v[j][1] * v[j][1]) + (v[j][2] * v[j][2] + v[j][3] * v[j][3]); }
    const float rstd = 1.0f / sqrtf(wave_sum(s2) * (1.0f / DM) + LN_EPS);
    float* XW = (float*)(ws + (dummy ? WS_X2 : WS_X));
    float* dst = (last && !dummy) ? (r < MP ? out + O_YP + (size_t)r * DM : out + O_YS + (size_t)(r - MP) * DM) : XW + (size_t)r * DM;
    const float* mrow = which == 1 ? mod + ((size_t)l * 12 + rb) * 12288 + 3 * 2048 : mod + ((size_t)(last ? l : l + 1) * 12 + rb) * 12288;
    bf16* H = (bf16*)(ws + (dummy ? WS_H2 : WS_H));
#pragma unroll
    for (int j = 0; j < 8; ++j) { const int c = 4 * lane + 256 * j;
        const f32x4 y = v[j] * rstd * *(const f32x4*)(gam + c) + *(const f32x4*)(bet + c);
        *(f32x4*)(dst + c) = y;
        if (!last) { const f32x4 h = y * (*(const f32x4*)(mrow + 2048 + c) + 1.0f) + *(const f32x4*)(mrow + c); v[j] = h;
            if (which == 2) { v2u w; w.x = pk2(h[0], h[1]); w.y = pk2(h[2], h[3]); *(v2u*)(H + (size_t)r * DM + c) = w; } } }
    if (!last) {
        float am = 0.f;
#pragma unroll
        for (int j = 0; j < 8; ++j) am = fmaxf(am, fmaxf(fmaxf(fabsf(v[j][0]), fabsf(v[j][1])), fmaxf(fabsf(v[j][2]), fabsf(v[j][3]))));
        am = wave_max(am);
        const float inv = am > 0.f ? 127.0f / am : 0.f;
        unsigned char* h8 = ws + (dummy ? WS_H2 + 17 * MiB : WS_H8) + (size_t)r * DM;
#pragma unroll
        for (int j = 0; j < 8; ++j) *(unsigned*)(h8 + 4 * lane + 256 * j) = q8x4(v[j][0], v[j][1], v[j][2], v[j][3], inv);
        if (lane == 0 && !dummy) ((float*)(ws + WS_HSC))[r] = am * (1.0f / 127.0f);
    }
}
__device__ __forceinline__ void phase_ln(const Ctx& C, int l, int which, const float* const* in, float* out, unsigned char* ws, bool dummy) {
    DECL_TID
    const int gw = C.bid * NWAVES + C.wave, NGW = C.G * NWAVES;
    for (int r = gw; r < MT; r += 2 * NGW) {
        const int r2 = r + NGW;
        f32x4 va[8], vb[8];
        ln_load(l, which, in, ws, r, LANE, va);
        if (r2 < MT) ln_load(l, which, in, ws, r2, LANE, vb);
        ln_finish(l, which, in, out, ws, dummy, r, LANE, va);
        if (r2 < MT) ln_finish(l, which, in, out, ws, dummy, r2, LANE, vb);
    }
}

template <int MODE>
__device__ __forceinline__ void mini_gemm(const Ctx& C, const bf16* A, int lda, const bf16* Bt, int N, int K, void* outp, int ldo) {
    DECL_TID
    const int fr = LANE & 15, fq = LANE >> 4, kw = K / 8;
    LAS float* red = (LAS float*)C.lds;
    for (int u = C.bid; u < N / 16; u += C.G) {
        f32x4 acc0 = (f32x4){0.f, 0.f, 0.f, 0.f}, acc1 = acc0;
        const bf16* bp = Bt + (size_t)(16 * u + fr) * K + C.wave * kw + 8 * fq;
        const bf16* ap0 = A + (size_t)fr * lda + C.wave * kw + 8 * fq; const bf16* ap1 = ap0 + (size_t)16 * lda;
#pragma unroll 8
        for (int k = 0; k < kw; k += 32) {
            const bf16x8 b = *(const bf16x8*)(bp + k), a0 = *(const bf16x8*)(ap0 + k), a1 = *(const bf16x8*)(ap1 + k);
            acc0 = MFMA16(a0, b, acc0); acc1 = MFMA16(a1, b, acc1);
        }
        *(LAS f32x4*)(red + ((C.wave * 2 + 0) * 64 + LANE) * 4) = acc0;
        *(LAS f32x4*)(red + ((C.wave * 2 + 1) * 64 + LANE) * 4) = acc1;
        __syncthreads();
        { const int rt = TID >> 8, ln = (TID >> 2) & 63, i = TID & 3; float s = 0.f;
#pragma unroll
          for (int w = 0; w < 8; ++w) s += red[((w * 2 + rt) * 64 + ln) * 4 + i];
          const int row = 16 * rt + 4 * (ln >> 4) + i, col = 16 * u + (ln & 15);
          if (MODE == 0) ((float*)outp)[(size_t)row * ldo + perm_in(pos16(col))] = s;
          else if (MODE == 1) ((float*)outp)[(size_t)row * ldo + col] = s;
          else { const float rl = fmaxf(s, 0.f); ((unsigned char*)outp)[(size_t)row * ldo + col] = (unsigned char)(fp8x2(rl * rl, 0.f) & 0xffu); } }
        __syncthreads();
    }
}

__device__ __forceinline__ void mini_gemm_fp8(const Ctx& C, const unsigned char* A, int lda, const unsigned char* Bt, int N, int K, float* outp, int ldo, float oscale) {
    DECL_TID
    const int fr = LANE & 15, fq = LANE >> 4, kw = K / 8;
    LAS float* red = (LAS float*)C.lds;
    for (int u = C.bid; u < N / 16; u += C.G) {
        f32x4 acc0 = (f32x4){0.f, 0.f, 0.f, 0.f}, acc1 = acc0;
        const unsigned char* bp = Bt + (size_t)(16 * u + fr) * K + C.wave * kw + 32 * fq;
        const unsigned char* ap0 = A + (size_t)fr * lda + C.wave * kw + 32 * fq; const unsigned char* ap1 = ap0 + (size_t)16 * lda;
#pragma unroll 4
        for (int k = 0; k < kw; k += 128) {
            const v8i_t b = __builtin_shufflevector(*(const v4i_t*)(bp + k), *(const v4i_t*)(bp + k + 16), 0, 1, 2, 3, 4, 5, 6, 7);
            const v8i_t a0 = __builtin_shufflevector(*(const v4i_t*)(ap0 + k), *(const v4i_t*)(ap0 + k + 16), 0, 1, 2, 3, 4, 5, 6, 7);
            const v8i_t a1 = __builtin_shufflevector(*(const v4i_t*)(ap1 + k), *(const v4i_t*)(ap1 + k + 16), 0, 1, 2, 3, 4, 5, 6, 7);
            acc0 = MFMA8(a0, b, acc0); acc1 = MFMA8(a1, b, acc1);
        }
        *(LAS f32x4*)(red + ((C.wave * 2 + 0) * 64 + LANE) * 4) = acc0;
        *(LAS f32x4*)(red + ((C.wave * 2 + 1) * 64 + LANE) * 4) = acc1;
        __syncthreads();
        { const int rt = TID >> 8, ln = (TID >> 2) & 63, i = TID & 3; float s = 0.f;
#pragma unroll
          for (int w = 0; w < 8; ++w) s += red[((w * 2 + rt) * 64 + ln) * 4 + i];
          const int row = 16 * rt + 4 * (ln >> 4) + i, col = 16 * u + (ln & 15);
          outp[(size_t)row * ldo + col] = s * oscale; }
        __syncthreads();
    }
}

template <int MODE>
__device__ __forceinline__ void mini_gemm_i8(const Ctx& C, const unsigned char* A, int lda, const float* hs, const unsigned char* Bt, const float* wsc, int N, int K, void* outp, int ldo) {
    DECL_TID
    const int fr = LANE & 15, fq = LANE >> 4, kw = K / 8;
    LAS int* red = (LAS int*)C.lds;
    for (int u = C.bid; u < N / 16; u += C.G) {
        v4i_t acc0 = (v4i_t){0, 0, 0, 0}, acc1 = acc0;
        const unsigned char* bp = Bt + (size_t)(16 * u + fr) * K + C.wave * kw + 16 * fq;
        const unsigned char* ap0 = A + (size_t)fr * lda + C.wave * kw + 16 * fq; const unsigned char* ap1 = ap0 + (size_t)16 * lda;
#pragma unroll
        for (int k = 0; k < kw; k += 64) {
            const v4i_t b = *(const v4i_t*)(bp + k), a0 = *(const v4i_t*)(ap0 + k), a1 = *(const v4i_t*)(ap1 + k);
            acc0 = MFMAI8(a0, b, acc0); acc1 = MFMAI8(a1, b, acc1);
        }
        *(LAS v4i_t*)(red + ((C.wave * 2 + 0) * 64 + LANE) * 4) = acc0;
        *(LAS v4i_t*)(red + ((C.wave * 2 + 1) * 64 + LANE) * 4) = acc1;
        __syncthreads();
        { const int rt = TID >> 8, ln = (TID >> 2) & 63, i = TID & 3; int s = 0;
#pragma unroll
          for (int w = 0; w < 8; ++w) s += red[((w * 2 + rt) * 64 + ln) * 4 + i];
          const int row = 16 * rt + 4 * (ln >> 4) + i, col = 16 * u + (ln & 15);
          const float val = (float)s * (hs[row] * wsc[col]);
          if (MODE == 0) { const float rl = fmaxf(val, 0.f); ((unsigned char*)outp)[(size_t)row * ldo + col] = (unsigned char)(fp8x2(rl * rl, 0.f) & 0xffu); }
          else ((float*)outp)[(size_t)row * ldo + perm_in(pos8(col))] = val; }
        __syncthreads();
    }
}

__device__ __forceinline__ void attn_unit(const Ctx& C, int uidx, const bf16* Z, bf16* ATTO, float* ATTL) {
    DECL_TID
    const int i16 = uidx & 15, rest = uidx >> 4, g = rest % 3, bh = rest / 3, h = bh & 3, b = bh >> 2;
    const int dil = 1 << (2 * g), r = i16 & (dil - 1), qblk = i16 >> (2 * g);
    const int fr = LANE & 15, fq = LANE >> 4, wave = C.wave;
    constexpr int PK = 272;
    LAS unsigned char* Kimg = C.lds; LAS unsigned char* Vimg = C.lds + 128 * PK;
    const size_t rs = (size_t)dil * DIN;
    const bf16* zb = Z + ((size_t)b * SEQ + r) * DIN;
    const int qc = OFF_QB + g * 512 + h * 128, kc = OFF_KB + g * 512 + h * 128, vc = OFF_VB + g * 512 + h * 128;
    const int m0 = qblk * 128, qi = 16 * wave + fr;
    bf16x8 qf[4];
    { const bf16* qp = zb + (size_t)(m0 + qi) * rs + qc + 8 * fq;
#pragma unroll
      for (int s = 0; s < 4; ++s) qf[s] = *(const bf16x8*)(qp + 32 * s); }
    float mrun = -1e30f, lrun = 0.f; f32x4 o[8];
#pragma unroll
    for (int dt = 0; dt < 8; ++dt) o[dt] = (f32x4){0.f, 0.f, 0.f, 0.f};
    for (int blk = (qblk > 0 ? 0 : 1); blk < 2; ++blk) {
        const int kb0 = m0 - 128 + blk * 128;
        __syncthreads();
#pragma unroll
        for (int i = 0; i < 4; ++i) { const int c = TID + NTHR * i, row = c >> 4, ch = c & 15; const bf16* src = zb + (size_t)(kb0 + row) * rs;
            const v4u kv = *(const v4u*)(src + kc + ch * 8), vv = *(const v4u*)(src + vc + ch * 8);
            *(LAS v4u*)(Kimg + row * PK + ch * 16) = kv; *(LAS v4u*)(Vimg + row * PK + ch * 16) = vv; }
        __syncthreads();
        const int kt_lo = blk == 0 ? wave : 0, kt_hi = blk == 0 ? 7 : wave;
        f32x4 sreg[8];
#pragma unroll
        for (int kt = 0; kt < 8; ++kt) {
            f32x4 acc = (f32x4){-1e30f, -1e30f, -1e30f, -1e30f};
            if (kt >= kt_lo && kt <= kt_hi) {
                acc = (f32x4){0.f, 0.f, 0.f, 0.f};
#pragma unroll
                for (int s = 0; s < 4; ++s) { const bf16x8 a = *(const LAS bf16x8*)(Kimg + (16 * kt + fr) * PK + (32 * s + 8 * fq) * 2); acc = MFMA16(a, qf[s], acc); }
#pragma unroll
                for (int i = 0; i < 4; ++i) { const int j = 16 * kt + 4 * fq + i; const bool ok = blk == 0 ? (j >= qi) : (j <= qi); acc[i] = ok ? acc[i] : -1e30f; }
            }
            sreg[kt] = acc;
        }
        float mx = -1e30f;
#pragma unroll
        for (int kt = 0; kt < 8; ++kt) mx = fmaxf(fmaxf(mx, fmaxf(sreg[kt][0], sreg[kt][1])), fmaxf(sreg[kt][2], sreg[kt][3]));
        mx = fmaxf(mx, __shfl_xor(mx, 16)); mx = fmaxf(mx, __shfl_xor(mx, 32));
        const float mnew = fmaxf(mrun, mx), corr = __builtin_amdgcn_exp2f(mrun - mnew);
        float ps = 0.f;
#pragma unroll
        for (int kt = 0; kt < 8; ++kt)
#pragma unroll
            for (int i = 0; i < 4; ++i) { const float p = __builtin_amdgcn_exp2f(sreg[kt][i] - mnew); sreg[kt][i] = p; ps += p; }
        ps += __shfl_xor(ps, 16); ps += __shfl_xor(ps, 32);
        lrun = lrun * corr + ps; mrun = mnew;
#pragma unroll
        for (int dt = 0; dt < 8; ++dt) o[dt] = o[dt] * corr;
#pragma unroll
        for (int s2 = 0; s2 < 4; ++s2) {
            if (2 * s2 + 1 >= kt_lo && 2 * s2 <= kt_hi) {
                const bf16x8 pb = pack8(sreg[2 * s2], sreg[2 * s2 + 1]);
#pragma unroll
                for (int dt = 0; dt < 8; ++dt) { const bf16x8 va = tr8(Vimg, PK, 32 * s2 + 4 * fq, 32 * s2 + 16 + 4 * fq, 16 * dt, LANE); o[dt] = MFMA16(va, pb, o[dt]); }
            }
        }
    }
    const float inv = 1.0f / lrun;
    const size_t row = (size_t)b * SEQ + (size_t)(m0 + qi) * dil + r;
    bf16* op = ATTO + ((size_t)g * MP + row) * 512 + h * 128 + 4 * fq;
#pragma unroll
    for (int dt = 0; dt < 8; ++dt) { v2u w; w.x = pk2(o[dt][0] * inv, o[dt][1] * inv); w.y = pk2(o[dt][2] * inv, o[dt][3] * inv); *(v2u*)(op + 16 * dt) = w; }
    if (fq == 0) ATTL[((size_t)g * MP + row) * 4 + h] = mrun + __builtin_amdgcn_logf(lrun);
}

__device__ __forceinline__ void ret_scan_unit(const Ctx& C, int uidx, int l, const bf16* Z, bf16* SPREV, float* out) {
    DECL_TID
    const int sl = uidx & 7, bh = uidx >> 3, h = bh & 3, b = bh >> 2;
    const int fr = LANE & 15, fq = LANE >> 4, wave = C.wave;
    constexpr int PK = 272, PS = 80;
    LAS unsigned char* Kimg = C.lds; LAS unsigned char* Vimg = C.lds + 128 * PK;
    const bf16* zb = Z + (size_t)b * SEQ * DIN;
    const int dvt = wave & 1, dk0 = (wave >> 1) * 2;
    const float lg = lg2_gamma(h), g128 = __builtin_amdgcn_exp2f(128.0f * lg), g127 = __builtin_amdgcn_exp2f(127.0f * lg);
    f32x4 S[2];
    S[0] = (f32x4){0.f, 0.f, 0.f, 0.f}; S[1] = S[0];
    v4u kreg[4], vreg;
    { const bf16* zr = zb;
#pragma unroll
      for (int i = 0; i < 4; ++i) { const int q = TID + NTHR * i, row = q >> 4, ch = q & 15; kreg[i] = *(const v4u*)(zr + (size_t)row * DIN + OFF_KC + h * 128 + ch * 8); }
      { const int row = TID >> 2, ch = TID & 3; vreg = *(const v4u*)(zr + (size_t)row * DIN + OFF_VC + h * 256 + sl * 32 + ch * 8); } }
    for (int c = 0; c < NCH; ++c) {
        __syncthreads();
#pragma unroll
        for (int i = 0; i < 4; ++i) { const int q = TID + NTHR * i, row = q >> 4, ch = q & 15; *(LAS v4u*)(Kimg + row * PK + ch * 16) = kreg[i]; }
        { const int row = TID >> 2, ch = TID & 3; *(LAS v4u*)(Vimg + row * PS + ch * 16) = vreg; }
        __syncthreads();
        if (c + 1 < NCH) { const bf16* zr = zb + (size_t)(c + 1) * 128 * DIN;
#pragma unroll
            for (int i = 0; i < 4; ++i) { const int q = TID + NTHR * i, row = q >> 4, ch = q & 15; kreg[i] = *(const v4u*)(zr + (size_t)row * DIN + OFF_KC + h * 128 + ch * 8); }
            { const int row = TID >> 2, ch = TID & 3; vreg = *(const v4u*)(zr + (size_t)row * DIN + OFF_VC + h * 256 + sl * 32 + ch * 8); } }
        bf16* sp = SPREV + ((size_t)bh * NCH + c) * 32768 + sl * 32 + 16 * dvt + 4 * fq;
#pragma unroll
        for (int j = 0; j < 2; ++j) { v2u w; w.x = pk2(S[j][0], S[j][1]); w.y = pk2(S[j][2], S[j][3]); *(v2u*)(sp + (size_t)(16 * (dk0 + j) + fr) * 256) = w; }
        f32x4 kv[2]; kv[0] = (f32x4){0.f, 0.f, 0.f, 0.f}; kv[1] = kv[0];
#pragma unroll
        for (int s = 0; s < 4; ++s) { const int m0 = 32 * s + 8 * fq;
            const bf16x8 a = tr8(Vimg, PS, m0, m0 + 4, 16 * dvt, LANE);
#pragma unroll
            for (int j = 0; j < 2; ++j) { const bf16x8 bk = tr8(Kimg, PK, m0, m0 + 4, 16 * (dk0 + j), LANE); kv[j] = MFMA16(a, bk, kv[j]); } }
#pragma unroll
        for (int j = 0; j < 2; ++j) S[j] = S[j] * g128 + kv[j] * g127;
    }
    float* o = out + O_RP + ((size_t)l * 16 + bh) * 32768 + sl * 32 + 16 * dvt + 4 * fq;
#pragma unroll
    for (int j = 0; j < 2; ++j) *(f32x4*)(o + (size_t)(16 * (dk0 + j) + fr) * 256) = S[j];
}

__device__ __forceinline__ void conv_unit(const Ctx& C, int uidx, int l, const bf16* Z, bf16* Y, const float* const* in) {
    DECL_TID
    const int b = uidx >> 6, t0 = (uidx & 63) * 32;
    LAS bf16* Uimg = (LAS bf16*)C.lds;
    LAS float* Cimg = (LAS float*)(C.lds + 63488);
    __syncthreads();
    for (int q = TID; q < 62 * 64; q += NTHR) { const int j = q >> 6, ch = q & 63, t = t0 - 30 + j;
        v4u v = (v4u){0u, 0u, 0u, 0u}; if (t >= 0) v = *(const v4u*)(Z + ((size_t)b * SEQ + t) * DIN + ch * 8);
        *(LAS v4u*)(Uimg + j * 512 + ch * 8) = v; }
    __syncthreads();
    { const int ch = TID; float w[31], uw[62];
      const float* cw = in[12] + (size_t)l * CONVK * WA + ch;
#pragma unroll
      for (int j = 0; j < 31; ++j) w[j] = cw[j * WA];
#pragma unroll
      for (int j = 0; j < 62; ++j) uw[j] = bf2f(Uimg[j * 512 + ch]);
      const float bias = in[13][l * WA + ch];
#pragma unroll
      for (int i = 0; i < 32; ++i) { float a = bias;
#pragma unroll
          for (int j = 0; j < 31; ++j) a += w[j] * uw[i + j];
          Cimg[i * 512 + ch] = a; } }
    __syncthreads();
    const float* lg = in[14] + (size_t)l * WA + 8 * LANE; const float* lb = in[15] + (size_t)l * WA + 8 * LANE;
#pragma unroll
    for (int k = 0; k < 4; ++k) { const int i = 4 * C.wave + k;
        const f32x4 v0 = *(const LAS f32x4*)(Cimg + i * 512 + 8 * LANE), v1 = *(const LAS f32x4*)(Cimg + i * 512 + 8 * LANE + 4);
        const float mean = wave_sum((v0[0] + v0[1]) + (v0[2] + v0[3]) + (v1[0] + v1[1]) + (v1[2] + v1[3])) * (1.0f / WA);
        const f32x4 d0 = v0 - mean, d1 = v1 - mean;
        const float var = wave_sum((d0[0] * d0[0] + d0[1] * d0[1]) + (d0[2] * d0[2] + d0[3] * d0[3]) + (d1[0] * d1[0] + d1[1] * d1[1]) + (d1[2] * d1[2] + d1[3] * d1[3])) * (1.0f / WA);
        const float rstd = 1.0f / sqrtf(var + LN_EPS);
        const f32x4 y0 = d0 * rstd * *(const f32x4*)lg + *(const f32x4*)lb, y1 = d1 * rstd * *(const f32x4*)(lg + 4) + *(const f32x4*)(lb + 4);
        v4u w; w.x = pk2(silu_f(y0[0]), silu_f(y0[1])); w.y = pk2(silu_f(y0[2]), silu_f(y0[3])); w.z = pk2(silu_f(y1[0]), silu_f(y1[1])); w.w = pk2(silu_f(y1[2]), silu_f(y1[3]));
        *(v4u*)(Y + ((size_t)b * SEQ + t0 + i) * DM + 8 * LANE) = w; }
}

__device__ __forceinline__ void conv_s_unit(const Ctx& C, int b, int l, const float* ZS, bf16* Y, const float* const* in, float* out) {
    DECL_TID
    LAS float* Cimg = (LAS float*)C.lds;
    __syncthreads();
    { const int ch = TID; float ue[34], w[31];
#pragma unroll
      for (int j = 0; j < 30; ++j) ue[j] = in[2][((size_t)(l * NBS + b) * 30 + j) * WA + ch];
#pragma unroll
      for (int t = 0; t < 4; ++t) { const float* zr = ZS + (size_t)(b * 4 + t) * DIN; ue[30 + t] = zr[OFF_A + ch] * sigm_f(zr[OFF_GA + ch]);
          out[O_CS + ((size_t)(l * NBS + b) * 30 + 26 + t) * WA + ch] = ue[30 + t]; }
      const float* cw = in[12] + (size_t)l * CONVK * WA + ch;
#pragma unroll
      for (int j = 0; j < 31; ++j) w[j] = cw[j * WA];
      const float bias = in[13][l * WA + ch];
#pragma unroll
      for (int t = 0; t < 4; ++t) { float a = bias;
#pragma unroll
          for (int j = 0; j < 31; ++j) a += w[j] * ue[t + j];
          Cimg[t * 512 + ch] = a; } }
    __syncthreads();
    if (C.wave < 4) { const int t = C.wave;
        const float* lg = in[14] + (size_t)l * WA + 8 * LANE; const float* lb = in[15] + (size_t)l * WA + 8 * LANE;
        const f32x4 v0 = *(const LAS f32x4*)(Cimg + t * 512 + 8 * LANE), v1 = *(const LAS f32x4*)(Cimg + t * 512 + 8 * LANE + 4);
        const float mean = wave_sum((v0[0] + v0[1]) + (v0[2] + v0[3]) + (v1[0] + v1[1]) + (v1[2] + v1[3])) * (1.0f / WA);
        const f32x4 d0 = v0 - mean, d1 = v1 - mean;
        const float var = wave_sum((d0[0] * d0[0] + d0[1] * d0[1]) + (d0[2] * d0[2] + d0[3] * d0[3]) + (d1[0] * d1[0] + d1[1] * d1[1]) + (d1[2] * d1[2] + d1[3] * d1[3])) * (1.0f / WA);
        const float rstd = 1.0f / sqrtf(var + LN_EPS);
        const f32x4 y0 = d0 * rstd * *(const f32x4*)lg + *(const f32x4*)lb, y1 = d1 * rstd * *(const f32x4*)(lg + 4) + *(const f32x4*)(lb + 4);
        v4u w; w.x = pk2(silu_f(y0[0]), silu_f(y0[1])); w.y = pk2(silu_f(y0[2]), silu_f(y0[3])); w.z = pk2(silu_f(y1[0]), silu_f(y1[1])); w.w = pk2(silu_f(y1[2]), silu_f(y1[3]));
        *(v4u*)(Y + ((size_t)MP + b * 4 + t) * DM + 8 * LANE) = w; }
}

__device__ __forceinline__ void attn_s_unit(const Ctx& C, int uidx, int l, const float* ZS, const float* rope, bf16* Y, const float* const* in, float* out) {
    DECL_TID
    const int t = uidx & 3, h = (uidx >> 2) & 3, b = uidx >> 4;
    LAS float* qrot = (LAS float*)C.lds;
    LAS float* knew = qrot + 384;
    LAS float* vnew = knew + 1536;
    LAS float* mw = vnew + 1536;
    LAS float* lw = mw + 8;
    LAS float* ow = lw + 8;
    __syncthreads();
    for (int i = TID; i < 3 * 64; i += NTHR) { const int g = i >> 6, f = i & 63; const float* zr = ZS + (size_t)(b * 4 + t) * DIN + OFF_QB + g * 512 + h * 128;
        const float x1 = zr[f], x2 = zr[64 + f], c = rope[((size_t)(2048 + t) * 64 + f) * 2], s = rope[((size_t)(2048 + t) * 64 + f) * 2 + 1];
        qrot[g * 128 + f] = (x1 * c - x2 * s) * SQ_ATT; qrot[g * 128 + 64 + f] = (x2 * c + x1 * s) * SQ_ATT; }
    for (int i = TID; i < 3 * 4 * 64; i += NTHR) { const int g = i >> 8, tt = (i >> 6) & 3, f = i & 63; const float* zr = ZS + (size_t)(b * 4 + tt) * DIN + OFF_KB + g * 512 + h * 128;
        const float x1 = zr[f], x2 = zr[64 + f], c = rope[((size_t)(2048 + tt) * 64 + f) * 2], s = rope[((size_t)(2048 + tt) * 64 + f) * 2 + 1];
        knew[(g * 4 + tt) * 128 + f] = x1 * c - x2 * s; knew[(g * 4 + tt) * 128 + 64 + f] = x2 * c + x1 * s; }
    for (int i = TID; i < 3 * 4 * 128; i += NTHR) { const int g = i >> 9, tt = (i >> 7) & 3, d = i & 127; vnew[i] = ZS[(size_t)(b * 4 + tt) * DIN + OFF_VB + g * 512 + h * 128 + d]; }
    __syncthreads();
    for (int i = TID; i < 3 * 256; i += NTHR) { const int g = i >> 8, kv = (i >> 7) & 1, d = i & 127, L = 128 << (2 * g);
        float* o = out + (g == 0 ? O_W1S : g == 1 ? O_W2S : O_W3S) + (((size_t)(l * NBS + b) * L + (L - 4 + t)) * 2 + kv) * 512 + h * 128 + d;
        *o = kv == 0 ? knew[(g * 4 + t) * 128 + d] : vnew[(g * 4 + t) * 128 + d]; }
    float m = -1e30f, ls = 0.f, o0 = 0.f, o1 = 0.f;
    const int d0 = 2 * LANE;
#pragma unroll
    for (int g = 0; g < 3; ++g) {
        const int dil = 1 << (2 * g), L = 128 << (2 * g), jmin = g == 0 ? t + 1 : 1;
        const float q0 = qrot[g * 128 + d0], q1 = qrot[g * 128 + d0 + 1];
        if (C.wave == 0) {
            for (int j = 0; j < jmin; ++j) { const int tn = t - dil * j;
                const float k0 = knew[(g * 4 + tn) * 128 + d0], k1 = knew[(g * 4 + tn) * 128 + d0 + 1], v0 = vnew[(g * 4 + tn) * 128 + d0], v1 = vnew[(g * 4 + tn) * 128 + d0 + 1];
                const float s = wave_sum(q0 * k0 + q1 * k1), mn = fmaxf(m, s), corr = __builtin_amdgcn_exp2f(m - mn), p = __builtin_amdgcn_exp2f(s - mn);
                ls = ls * corr + p; o0 = o0 * corr + p * v0; o1 = o1 * corr + p * v1; m = mn; }
        }
        const float* cb = (g == 0 ? in[3] : g == 1 ? in[4] : in[5]) + (size_t)(l * NBS + b) * L * 1024 + h * 128 + d0;
        for (int j0 = jmin + C.wave; j0 <= 128; j0 += 32) {
            f32x2 kk[4], vv[4];
#pragma unroll
            for (int u = 0; u < 4; ++u) { const int j = j0 + 8 * u, jc = j <= 128 ? j : 128; const float* kp = cb + (size_t)(L + t - dil * jc) * 1024; kk[u] = *(const f32x2*)kp; vv[u] = *(const f32x2*)(kp + 512); }
#pragma unroll
            for (int u = 0; u < 4; ++u) { float s = wave_sum(q0 * kk[u][0] + q1 * kk[u][1]); if (j0 + 8 * u > 128) s = -1e30f;
                const float mn = fmaxf(m, s), corr = __builtin_amdgcn_exp2f(m - mn), p = __builtin_amdgcn_exp2f(s - mn);
                ls = ls * corr + p; o0 = o0 * corr + p * vv[u][0]; o1 = o1 * corr + p * vv[u][1]; m = mn; }
        }
    }
    if (LANE == 0) { mw[C.wave] = m; lw[C.wave] = ls; }
    ow[C.wave * 128 + d0] = o0; ow[C.wave * 128 + d0 + 1] = o1;
    __syncthreads();
    if (TID < 128) { float M = -1e30f;
#pragma unroll
        for (int w = 0; w < 8; ++w) M = fmaxf(M, mw[w]);
        float num = 0.f, den = 0.f;
#pragma unroll
        for (int w = 0; w < 8; ++w) { const float e = __builtin_amdgcn_exp2f(mw[w] - M); num += e * ow[w * 128 + TID]; den += e * lw[w]; }
        Y[((size_t)MP + b * 4 + t) * DM + WA + h * 128 + TID] = (bf16)f2bf(num / den); }
}

__device__ __forceinline__ void ret_s_unit(const Ctx& C, int uidx, int l, const float* ZS, const float* rope, bf16* Y, const float* const* in, float* out) {
    DECL_TID
    const int h = uidx & 3, b = uidx >> 2;
    LAS float* qs = (LAS float*)C.lds;
    LAS float* ks = qs + 512;
    LAS float* vs = ks + 512;
    LAS float* cp = vs + 1024;
    LAS float* aa = cp + 2048;
    LAS float* oo = aa + 16;
    __syncthreads();
    for (int i = TID; i < 4 * 64; i += NTHR) { const int tt = i >> 6, f = i & 63; const float* zr = ZS + (size_t)(b * 4 + tt) * DIN;
        const float c = rope[((size_t)(2048 + tt) * 64 + f) * 2], s = rope[((size_t)(2048 + tt) * 64 + f) * 2 + 1];
        float x1 = zr[OFF_QC + h * 128 + f], x2 = zr[OFF_QC + h * 128 + 64 + f]; qs[tt * 128 + f] = x1 * c - x2 * s; qs[tt * 128 + 64 + f] = x2 * c + x1 * s;
        x1 = zr[OFF_KC + h * 128 + f]; x2 = zr[OFF_KC + h * 128 + 64 + f]; ks[tt * 128 + f] = (x1 * c - x2 * s) * KS_RET; ks[tt * 128 + 64 + f] = (x2 * c + x1 * s) * KS_RET; }
    for (int i = TID; i < 1024; i += NTHR) vs[i] = ZS[(size_t)(b * 4 + (i >> 8)) * DIN + OFF_VC + h * 256 + (i & 255)];
    __syncthreads();
    const float g1 = __builtin_amdgcn_exp2f(lg2_gamma(h)), g2 = g1 * g1, g3 = g2 * g1, g4 = g2 * g2;
    const int e = TID & 255, dh = TID >> 8;
    { const float v0 = vs[e], v1 = vs[256 + e], v2 = vs[512 + e], v3 = vs[768 + e];
      float cr[4] = {0.f, 0.f, 0.f, 0.f};
      const size_t sbase = ((size_t)(l * NBS + b) * NHC + h) * 32768;
      const float* sp = in[6] + sbase; float* so = out + O_RS + sbase;
#pragma unroll 8
      for (int d = dh * 64; d < dh * 64 + 64; ++d) { const float S = sp[(size_t)d * 256 + e];
          cr[0] += qs[d] * S; cr[1] += qs[128 + d] * S; cr[2] += qs[256 + d] * S; cr[3] += qs[384 + d] * S;
          so[(size_t)d * 256 + e] = g4 * S + (g3 * ks[d] * v0 + g2 * ks[128 + d] * v1) + (g1 * ks[256 + d] * v2 + ks[384 + d] * v3); }
#pragma unroll
      for (int n = 0; n < 4; ++n) cp[(dh * 4 + n) * 256 + e] = cr[n]; }
    if (TID < 16) { const int n = TID >> 2, mm = TID & 3; float a = 0.f; for (int d = 0; d < 128; ++d) a += qs[n * 128 + d] * ks[mm * 128 + d]; aa[TID] = a; }
    __syncthreads();
    { const float v[4] = {vs[e], vs[256 + e], vs[512 + e], vs[768 + e]};
#pragma unroll
      for (int k = 0; k < 2; ++k) { const int n = 2 * dh + k; float gp = 1.f, o = 0.f;
#pragma unroll
          for (int mm = 3; mm >= 0; --mm) if (mm <= n) { o += gp * aa[n * 4 + mm] * v[mm]; gp *= g1; }
          oo[n * 256 + e] = o + gp * (cp[n * 256 + e] + cp[(4 + n) * 256 + e]); } }
    __syncthreads();
    if (C.wave < 4) { const int n = C.wave; const f32x4 v = *(const LAS f32x4*)(oo + n * 256 + 4 * LANE);
        const float mean = wave_sum((v[0] + v[1]) + (v[2] + v[3])) * (1.0f / 256.0f); const f32x4 d = v - mean;
        const float var = wave_sum((d[0] * d[0] + d[1] * d[1]) + (d[2] * d[2] + d[3] * d[3])) * (1.0f / 256.0f); const float rstd = 1.0f / sqrtf(var + LN_EPS);
        const f32x4 gt = *(const f32x4*)(ZS + (size_t)(b * 4 + n) * DIN + OFF_GC + h * 256 + 4 * LANE);
        v2u w; w.x = pk2(silu_f(gt[0]) * d[0] * rstd, silu_f(gt[1]) * d[1] * rstd); w.y = pk2(silu_f(gt[2]) * d[2] * rstd, silu_f(gt[3]) * d[3] * rstd);
        *(v2u*)(Y + ((size_t)MP + b * 4 + n) * DM + 1024 + h * 256 + 4 * LANE) = w; }
}

__device__ __forceinline__ void ret_out_unit(const Ctx& C, int uidx, const bf16* Z, const bf16* SPREV, bf16* Y) {
    DECL_TID
    const int c = uidx & 15, bh = uidx >> 4, h = bh & 3, b = bh >> 2;
    const int fr = LANE & 15, fq = LANE >> 4, wave = C.wave;
    constexpr int PV = 528;
    LAS unsigned char* Simg = C.lds; LAS unsigned char* Vimg = C.lds + 128 * PV;
    const size_t row0 = (size_t)b * SEQ + c * 128;
    const bf16* zr = Z + row0 * DIN;
    const float lg = lg2_gamma(h);
    __syncthreads();
    if (c > 0) { const bf16* sp = SPREV + ((size_t)bh * NCH + c) * 32768;
#pragma unroll
        for (int i = 0; i < 8; ++i) { const int q = TID + NTHR * i, row = q >> 5, ch = q & 31; *(LAS v4u*)(Simg + row * PV + ch * 16) = *(const v4u*)(sp + (size_t)row * 256 + ch * 8); } }
#pragma unroll
    for (int i = 0; i < 8; ++i) { const int q = TID + NTHR * i, row = q >> 5, ch = q & 31;
        *(LAS v4u*)(Vimg + row * PV + ch * 16) = *(const v4u*)(zr + (size_t)row * DIN + OFF_VC + h * 256 + ch * 8); }
    __syncthreads();
    const int n = 16 * wave + fr;
    bf16x8 qf[4];
#pragma unroll
    for (int s = 0; s < 4; ++s) qf[s] = *(const bf16x8*)(zr + (size_t)n * DIN + OFF_QC + h * 128 + 32 * s + 8 * fq);
    f32x4 o[16];
#pragma unroll
    for (int i = 0; i < 16; ++i) o[i] = (f32x4){0.f, 0.f, 0.f, 0.f};
    if (c > 0) {
#pragma unroll
        for (int s = 0; s < 4; ++s) { const int k0 = 32 * s + 8 * fq;
#pragma unroll
            for (int dvt = 0; dvt < 16; ++dvt) { const bf16x8 a = tr8(Simg, PV, k0, k0 + 4, 16 * dvt, LANE); o[dvt] = MFMA16(a, qf[s], o[dvt]); } }
        const float g1 = __builtin_amdgcn_exp2f(lg);
#pragma unroll
        for (int i = 0; i < 16; ++i) o[i] = o[i] * g1;
    }
#pragma unroll
    for (int s2 = 0; s2 < 4; ++s2) {
        if (2 * s2 <= wave) {
            f32x4 p0 = (f32x4){0.f, 0.f, 0.f, 0.f}, p1 = p0;
            { const bf16* kp = zr + (size_t)(32 * s2 + fr) * DIN + OFF_KC + h * 128 + 8 * fq;
#pragma unroll
              for (int s = 0; s < 4; ++s) { const bf16x8 a = *(const bf16x8*)(kp + 32 * s); p0 = MFMA16(a, qf[s], p0); }
#pragma unroll
              for (int i = 0; i < 4; ++i) p0[i] = (32 * s2 + 4 * fq + i <= n) ? p0[i] : 0.f; }
            if (2 * s2 + 1 <= wave) { const bf16* kp = zr + (size_t)(32 * s2 + 16 + fr) * DIN + OFF_KC + h * 128 + 8 * fq;
#pragma unroll
              for (int s = 0; s < 4; ++s) { const bf16x8 a = *(const bf16x8*)(kp + 32 * s); p1 = MFMA16(a, qf[s], p1); }
#pragma unroll
              for (int i = 0; i < 4; ++i) p1[i] = (32 * s2 + 16 + 4 * fq + i <= n) ? p1[i] : 0.f; }
            const bf16x8 pb = pack8(p0, p1);
#pragma unroll
            for (int dvt = 0; dvt < 16; ++dvt) { const bf16x8 a = tr8(Vimg, PV, 32 * s2 + 4 * fq, 32 * s2 + 16 + 4 * fq, 16 * dvt, LANE); o[dvt] = MFMA16(a, pb, o[dvt]); }
        }
    }
    float s = 0.f;
#pragma unroll
    for (int i = 0; i < 16; ++i) s += (o[i][0] + o[i][1]) + (o[i][2] + o[i][3]);
    s += __shfl_xor(s, 16); s += __shfl_xor(s, 32);
    const float mean = s * (1.0f / 256.0f); float q = 0.f;
#pragma unroll
    for (int i = 0; i < 16; ++i) { o[i] = o[i] - mean; q += (o[i][0] * o[i][0] + o[i][1] * o[i][1]) + (o[i][2] * o[i][2] + o[i][3] * o[i][3]); }
    q += __shfl_xor(q, 16); q += __shfl_xor(q, 32);
    const float rstd = 1.0f / sqrtf(q * (1.0f / 256.0f) + LN_EPS);
    const bf16* gp = zr + (size_t)n * DIN + OFF_GC + h * 256 + 4 * fq; bf16* yp = Y + (row0 + n) * DM + 1024 + h * 256 + 4 * fq;
#pragma unroll
    for (int i = 0; i < 16; ++i) { const v2u gw = *(const v2u*)(gp + 16 * i);
        v2u w; w.x = pk2(silu_f(bflo(gw.x)) * o[i][0] * rstd, silu_f(bfhi(gw.x)) * o[i][1] * rstd); w.y = pk2(silu_f(bflo(gw.y)) * o[i][2] * rstd, silu_f(bfhi(gw.y)) * o[i][3] * rstd);
        *(v2u*)(yp + 16 * i) = w; }
}
__device__ __forceinline__ void attn_merge_rows(const Ctx& C, const bf16* ATTO, const float* ATTL, bf16* Y) {
    DECL_TID
    const int gw = C.bid * NWAVES + C.wave, NGW = C.G * NWAVES, hh = LANE >> 4;
    for (int r = gw; r < MP; r += NGW) {
        const float l0 = ATTL[((size_t)0 * MP + r) * 4 + hh], l1 = ATTL[((size_t)1 * MP + r) * 4 + hh], l2 = ATTL[((size_t)2 * MP + r) * 4 + hh];
        const float mx = fmaxf(l0, fmaxf(l1, l2));
        float w0 = __builtin_amdgcn_exp2f(l0 - mx), w1 = __builtin_amdgcn_exp2f(l1 - mx), w2 = __builtin_amdgcn_exp2f(l2 - mx);
        const float inv = 1.0f / (w0 + w1 + w2); w0 *= inv; w1 *= inv; w2 *= inv;
        const v4u a = *(const v4u*)(ATTO + ((size_t)0 * MP + r) * 512 + 8 * LANE), bq = *(const v4u*)(ATTO + ((size_t)1 * MP + r) * 512 + 8 * LANE), cq = *(const v4u*)(ATTO + ((size_t)2 * MP + r) * 512 + 8 * LANE);
        v4u o;
        o.x = pk2(w0 * bflo(a.x) + w1 * bflo(bq.x) + w2 * bflo(cq.x), w0 * bfhi(a.x) + w1 * bfhi(bq.x) + w2 * bfhi(cq.x));
        o.y = pk2(w0 * bflo(a.y) + w1 * bflo(bq.y) + w2 * bflo(cq.y), w0 * bfhi(a.y) + w1 * bfhi(bq.y) + w2 * bfhi(cq.y));
        o.z = pk2(w0 * bflo(a.z) + w1 * bflo(bq.z) + w2 * bflo(cq.z), w0 * bfhi(a.z) + w1 * bfhi(bq.z) + w2 * bfhi(cq.z));
        o.w = pk2(w0 * bflo(a.w) + w1 * bflo(bq.w) + w2 * bflo(cq.w), w0 * bfhi(a.w) + w1 * bfhi(bq.w) + w2 * bfhi(cq.w));
        *(v4u*)(Y + (size_t)r * DM + WA + 8 * LANE) = o;
    }
}
#ifndef PHMASK
#define PHMASK 0xFFFFFFu
#endif
#define PM(k) ((PHMASK >> (k)) & 1u)
constexpr int NPH = 2 + 8 * DEPTH;
struct Args { const float* in[23]; float* out; unsigned char* ws; int ph_lo, ph_hi; };
static_assert(sizeof(Args) == 23 * 8 + 8 + 8 + 8, "Args has no padding");

__global__ void __launch_bounds__(NTHR, 2) fwd(Args args) {
    extern __shared__ __attribute__((aligned(16))) unsigned char lds_raw[];
    Ctx C;
    C.lds = (LAS unsigned char*)lds_raw;
    C.wave = __builtin_amdgcn_readfirstlane((int)(threadIdx.x >> 6)); C.bid = blockIdx.x; C.G = gridDim.x;
    volatile LAS unsigned* MISC = (volatile LAS unsigned*)(C.lds + MISC_OFF);
    for (int u = (int)threadIdx.x; u < (LDS_BYTES - MISC_OFF) / 4; u += NTHR) MISC[u] = 0u;
    __syncthreads();
    unsigned char* ws = args.ws; float* out = args.out; const float* const* in = args.in;
    XcdBarrier bar = xcd_barrier_post((unsigned*)(ws + WS_CTL) + CW_BAR, MISC + 8);
    const int lo = args.ph_lo, hi = args.ph_hi;
#define IN(k) (lo <= (k) && (k) < hi)
#define SEAM(k) do { if (IN(k) && IN((k) + 1)) xcd_barrier(bar); } while (0)

    float* mod = (float*)(ws + WS_MOD); float* rope = (float*)(ws + WS_ROPE);
    bf16* H = (bf16*)(ws + WS_H); bf16* Z = (bf16*)(ws + WS_Z); bf16* Y = (bf16*)(ws + WS_Y); unsigned char* F = ws + WS_F;
    float* X = (float*)(ws + WS_X); bf16* ATTO = (bf16*)(ws + WS_ATTO); float* ATTL = (float*)(ws + WS_ATTL); bf16* SPREV = (bf16*)(ws + WS_KV);
    float* ZS = (float*)(ws + WS_ZS); float* TSr = (float*)(ws + WS_TS); unsigned char* FS = ws + WS_FS;

    if (PM(0) && IN(0)) { for (int rep = 0; rep < 1 + DUP(0); ++rep) phase_mod(C, in[7], in[8], in[9], in[10], mod, rope, in[19], (float*)(ws + WS_WSC), in[11], (float*)(ws + WS_WSCI)); }
    SEAM(0);
    if (PM(1) && IN(1)) { for (int rep = 0; rep < 1 + DUP(1); ++rep) phase_prep(C, in, out, ws); }
    SEAM(1);

    for (int l = 0; l < DEPTH; ++l) {
        const int pb = 2 + 8 * l;
        const bf16* Wi = (const bf16*)(ws + WS_WIN) + (size_t)l * NIN16 * DM; const unsigned char* Wi8 = ws + WS_WIN8 + (size_t)l * NIN8 * DM; const float* wsci = (const float*)(ws + WS_WSCI) + l * NIN8; const bf16* Wo = (const bf16*)(ws + WS_WO) + (size_t)l * DM * DM;
        const unsigned char* Wu = ws + WS_WUP + (size_t)l * DFF * DM; const float* wsc = (const float*)(ws + WS_WSC) + l * DFF; const unsigned char* Wd = ws + WS_WDN + (size_t)l * DM * DFF;
        if (PM(2) && IN(pb + 0)) for (int rep = 0; rep < 1 + DUP(2); ++rep) {
            const unsigned char* H8 = ws + WS_H8; const float* hsc = (const float*)(ws + WS_HSC);
            mini_gemm<0>(C, H + (size_t)MP * DM, DM, Wi, NIN16, DM, ZS, DIN);
            mini_gemm_i8<1>(C, H8 + (size_t)MP * DM, DM, hsc + MP, Wi8, wsci, NIN8, DM, ZS, DIN);
            {
                pg8::Gemm g{H, Wi, MP, NIN16, DM}; pg8::StaticOrder S; S.init(MP, NIN16, C.G, C.bid);
                pg8::EpiZ<false> E{Z, rope, out, l, hsc, wsci};
                pg8::gemm_phase<pg8::EpiZ<false>, pg8::StaticOrder, true, true>(C.lds, g, S, E);
            }
            {
                pg8::Gemm g{(const bf16*)H8, (const bf16*)Wi8, MP, NIN8, DM / 2}; pg8::SplitOrder S; S.init(MP, NIN8, C.G, C.bid, (MP / 256) * (NIN16 / 256));
                pg8::EpiZ<true> E{Z, rope, out, l, hsc, wsci};
                pg8::gemm_phase<pg8::EpiZ<true>, pg8::SplitOrder, true, true, 2>(C.lds, g, S, E);
            }
        }
        SEAM(pb + 0);
        if (PM(3) && IN(pb + 1)) for (int rep = 0; rep < 1 + DUP(3); ++rep) {
            for (int u = C.bid; u < 1320; u += C.G) {
                if (u < 768) { if (PM(10)) attn_unit(C, u, Z, ATTO, ATTL); }
                else if (u < 896) { if (PM(11)) ret_scan_unit(C, u - 768, l, Z, SPREV, out); }
                else if (u < 1152) { if (PM(12)) conv_unit(C, u - 896, l, Z, Y, in); }
                else if (u < 1160) { if (PM(13)) conv_s_unit(C, u - 1152, l, ZS, Y, in, out); }
                else if (u < 1288) { if (PM(14)) attn_s_unit(C, u - 1160, l, ZS, rope, Y, in, out); }
                else { if (PM(15)) ret_s_unit(C, u - 1288, l, ZS, rope, Y, in, out); }
            }
        }
        SEAM(pb + 1);
        if (PM(4) && IN(pb + 2)) for (int rep = 0; rep < 1 + DUP(4); ++rep) {
            for (int u = C.bid; u < 256; u += C.G) { if (PM(16)) ret_out_unit(C, u, Z, SPREV, Y); }
            if (PM(18)) attn_merge_rows(C, ATTO, ATTL, Y);
        }
        SEAM(pb + 2);
        if (PM(5) && IN(pb + 3)) for (int rep = 0; rep < 1 + DUP(5); ++rep) {
            __syncthreads();
            mini_gemm<1>(C, Y + (size_t)MP * DM, DM, Wo, DM, DM, TSr, DM);
            pg8::Gemm g{Y, Wo, MP, DM, DM}; pg8::StaticOrder S; S.init(MP, DM, C.G, C.bid);
            pg8::EpiRes E{l == 0 ? in[0] : X, rep < DUP(5) ? (float*)(ws + WS_X2) : X, mod + (size_t)l * 12 * 12288 + 2 * 2048, 1.0f};
            pg8::gemm_phase<pg8::EpiRes, pg8::StaticOrder, true, true>(C.lds, g, S, E);
        }
        SEAM(pb + 3);
        if (PM(6) && IN(pb + 4)) for (int rep = 0; rep < 1 + DUP(6); ++rep) phase_ln(C, l, 1, in, out, ws, rep < DUP(6));
        SEAM(pb + 4);
        if (PM(7) && IN(pb + 5)) for (int rep = 0; rep < 1 + DUP(7); ++rep) {
            const unsigned char* H8 = ws + WS_H8; const float* hsc = (const float*)(ws + WS_HSC);
            mini_gemm_i8<0>(C, H8 + (size_t)MP * DM, DM, hsc + MP, Wu, wsc, DFF, DM, FS, DFF);
            pg8::Gemm g{(const bf16*)H8, (const bf16*)Wu, MP, DFF, DM / 2}; pg8::StaticOrder S; S.init(MP, DFF, C.G, C.bid);
            pg8::EpiUp E{F, hsc, wsc};
            pg8::gemm_phase<pg8::EpiUp, pg8::StaticOrder, true, true, 2>(C.lds, g, S, E);
        }
        SEAM(pb + 5);
        if (PM(8) && IN(pb + 6)) for (int rep = 0; rep < 1 + DUP(8); ++rep) {
            mini_gemm_fp8(C, FS, DFF, Wd, DM, DFF, TSr, DM, 1.0f / WDN_SCALE);
            pg8::Gemm g{(const bf16*)F, (const bf16*)Wd, MP, DM, DFF / 2}; pg8::StaticOrder S; S.init(MP, DM, C.G, C.bid);
            pg8::EpiRes E{X, rep < DUP(8) ? (float*)(ws + WS_X2) : X, mod + (size_t)l * 12 * 12288 + 5 * 2048, 1.0f / WDN_SCALE};
            pg8::gemm_phase<pg8::EpiRes, pg8::StaticOrder, true, true, 1>(C.lds, g, S, E);
        }
        SEAM(pb + 6);
        if (PM(9) && IN(pb + 7)) for (int rep = 0; rep < 1 + DUP(9); ++rep) phase_ln(C, l, 2, in, out, ws, rep < DUP(9));
        SEAM(pb + 7);
    }
#undef IN
#undef SEAM
}

extern "C" void kernel_launch(void* const* d_in, const int* in_sizes, int n_in, void* d_out, int out_size, void* d_ws, size_t ws_size, hipStream_t stream) {
    static int grid = 0;
    if (grid == 0) {
        if (n_in != 23 || (size_t)out_size != O_END || ws_size < WS_END) { fprintf(stderr, "kernel_launch: unexpected sizes n_in %d out %d ws %zu\n", n_in, out_size, ws_size); grid = -1; return; }
        int dev = 0, cus = 0, per_cu = 0;
        if (hipGetDevice(&dev) != hipSuccess || hipDeviceGetAttribute(&cus, hipDeviceAttributeMultiprocessorCount, dev) != hipSuccess) { grid = -1; return; }
        if (hipFuncSetAttribute((const void*)fwd, hipFuncAttributeMaxDynamicSharedMemorySize, LDS_BYTES) != hipSuccess) { fprintf(stderr, "kernel_launch: hipFuncSetAttribute failed\n"); grid = -1; return; }
        if (hipOccupancyMaxActiveBlocksPerMultiprocessor(&per_cu, (const void*)fwd, NTHR, LDS_BYTES) != hipSuccess || per_cu < 1) fprintf(stderr, "kernel_launch: occupancy query reports %d\n", per_cu);
        (void)hipGetLastError();
        grid = cus;
    }
    if (grid < 0) return;
    (void)hipMemsetAsync((char*)d_ws + WS_CTL, 0, CTL_ZERO_BYTES, stream);
    Args a{};
    for (int i = 0; i < 23; ++i) a.in[i] = (const float*)d_in[i];
    a.out = (float*)d_out; a.ws = (unsigned char*)d_ws;
#if MK_ONE_LAUNCH
    a.ph_lo = 0; a.ph_hi = NPH;
    hipLaunchKernelGGL(fwd, dim3(grid), dim3(NTHR), LDS_BYTES, stream, a);
#else
    for (int p = 0; p < NPH; ++p) { a.ph_lo = p; a.ph_hi = p + 1; hipLaunchKernelGGL(fwd, dim3(grid), dim3(NTHR), LDS_BYTES, stream, a); }
#endif
}
```

```cpp
#include <hip/hip_runtime.h>
#include <cstdio>
#include <cstdint>

#ifndef PROBE_DUP
#define PROBE_DUP 0x0u
#endif
#define DUP(k) ((int)((PROBE_DUP >> (k)) & 1u))
#ifndef MK_ONE_LAUNCH
#define MK_ONE_LAUNCH 1
#endif

constexpr int DM = 2048, NB = 4, SEQ = 2048, DEPTH = 4, NBS = 8, TS = 4, PAST = 16384;
constexpr int WA = 512, CONVK = 31, HDB = 128, WB = 512, NHB = 4, NDIL = 3;
constexpr int WC = 1024, NHC = 4, DVC = 256, DKC = 128, RCH = 128, NCH = SEQ / RCH;
constexpr int DIN = 8704, DFF = 8192;
constexpr int MP = NB * SEQ;
constexpr int MS = NBS * TS;
constexpr int MT = MP + MS;
constexpr int OFF_A = 0, OFF_GA = 512, OFF_QB = 1024, OFF_KB = 2560, OFF_VB = 4096, OFF_QC = 5632, OFF_KC = 6144, OFF_VC = 6656, OFF_GC = 7680;
constexpr float LN_EPS = 1e-5f;
constexpr float ALPHA = 1.681792830507429f;
constexpr float SQ_ATT = 0.12751743082459868f;
constexpr float KS_RET = 0.08838834764831845f;
constexpr float LOG2E = 1.4426950408889634f;
__device__ __forceinline__ float lg2_gamma(int h) { return h == 0 ? -0.04580368961312479f : h == 1 ? -0.02272007650008353f : h == 2 ? -0.011315313227834146f : -0.005646563141142063f; }

constexpr size_t O_YP = 0, O_YS = O_YP + (size_t)MP * DM, O_CP = O_YS + (size_t)MS * DM, O_CS = O_CP + (size_t)DEPTH * NB * 30 * WA,
    O_W1P = O_CS + (size_t)DEPTH * NBS * 30 * WA, O_W1S = O_W1P + (size_t)DEPTH * NB * 128 * 1024, O_W2P = O_W1S + (size_t)DEPTH * NBS * 128 * 1024,
    O_W2S = O_W2P + (size_t)DEPTH * NB * 512 * 1024, O_W3P = O_W2S + (size_t)DEPTH * NBS * 512 * 1024, O_W3S = O_W3P + (size_t)DEPTH * NB * 2048 * 1024,
    O_RP = O_W3S + (size_t)DEPTH * NBS * 2048 * 1024, O_RS = O_RP + (size_t)DEPTH * NB * NHC * DKC * DVC, O_END = O_RS + (size_t)DEPTH * NBS * NHC * DKC * DVC;
static_assert(O_END == 155992064ull, "output size");

constexpr size_t MiB = 1u << 20;
constexpr size_t WS_CTL = 0, CTL_ZERO_BYTES = 1 * MiB;
constexpr size_t WS_MOD = 1 * MiB;
constexpr size_t WS_ROPE = 4 * MiB;
constexpr size_t WS_WIN = 8 * MiB;
constexpr size_t WS_WIN8 = 108 * MiB;
constexpr size_t WS_WSCI = 3 * MiB + 640 * 1024;
constexpr int NIN16 = 5632, NIN8 = 3072;
constexpr size_t WS_WO = 144 * MiB;
constexpr size_t WS_WUP = 176 * MiB;
constexpr size_t WS_WDN = 304 * MiB;
constexpr size_t WS_X = 432 * MiB;
constexpr size_t WS_H = 498 * MiB;
constexpr size_t WS_Z = 532 * MiB;
constexpr size_t WS_Y = 668 * MiB;
constexpr size_t WS_F = 702 * MiB;
constexpr size_t WS_ATTO = 830 * MiB;
constexpr size_t WS_ATTL = 854 * MiB;
constexpr size_t WS_KV = 855 * MiB;
constexpr size_t WS_ZS = 887 * MiB;
constexpr size_t WS_TS = 889 * MiB;
constexpr size_t WS_FS = 890 * MiB;
constexpr size_t WS_X2 = 891 * MiB;
constexpr size_t WS_H2 = 957 * MiB;
constexpr size_t WS_H8 = 991 * MiB;
constexpr size_t WS_WSC = 3 * MiB + 512 * 1024;
constexpr size_t WS_HSC = 3 * MiB + 768 * 1024;
constexpr size_t WS_END = 1008 * MiB;
constexpr int CW_BAR = 4096;
constexpr int CW_AMAX_UP = 16384, CW_AMAX_IN = 49152;
constexpr float QS = 1.0f / 127.0f;

constexpr int SCR_BYTES = 143360;
constexpr int MISC_OFF = SCR_BYTES;
constexpr int LDS_BYTES = 147456;
constexpr int NWAVES = 8, NTHR = 512;
__host__ __device__ __forceinline__ int map16(int j) { return j < 4 ? j : j < 16 ? j + 6 : j + 8; }
__host__ __device__ __forceinline__ int map8(int j) { return j < 6 ? j + 4 : j < 8 ? j + 16 : j + 22; }
__host__ __device__ __forceinline__ int pos16(int c) { return map16(c >> 8) * 256 + (c & 255); }
__host__ __device__ __forceinline__ int pos8(int c) { return map8(c >> 8) * 256 + (c & 255); }
namespace pg8 {
#define PG8_LAS __attribute__((address_space(3)))
typedef unsigned short bf16_t;
typedef short bf16x8 __attribute__((ext_vector_type(8)));
typedef float f32x4 __attribute__((ext_vector_type(4)));
typedef unsigned u32x4 __attribute__((ext_vector_type(4)));
typedef int i32x4_t __attribute__((ext_vector_type(4)));
constexpr int BM = 256, BK = 64, HALF = 128, HTB = HALF * BK * 2  , STAGE_BYTES = 8 * HTB, NXCD = 8, WGM = 8;

__host__ __device__ __forceinline__ int lds_byte(int r, int c) { const int st = (r >> 4) * 2 + (c >> 5), rr = r & 15, cc = c & 31, ob = rr * 64 + cc * 2; return st * 1024 + (ob ^ (((ob >> 9) & 1) << 5)); }
__host__ __device__ __forceinline__ void stage_rc(int b, int& R, int& C) { const int st = b / 1024, sb = b % 1024, swz = sb ^ (((sb >> 9) & 1) << 5); R = (st >> 1) * 16 + swz / 64; C = (st & 1) * 32 + (swz % 64) / 2; }
__host__ __device__ __forceinline__ int perm32(int rho) { const int n = rho >> 4, i = rho & 15; return 8 * (i >> 2) + 4 * n + (i & 3); }

struct Unit { int pm, pn; };
struct Gemm { const bf16_t* A; const bf16_t* Bt; int M, N, K; };

struct StaticOrder {
    int nM, nN, nwg, G, c;
    __host__ __device__ void init(int M, int N, int G_, int c_) { nM = M / BM; nN = N / BM; nwg = nM * nN; G = G_; c = c_; }
    __host__ __device__ bool next(int i, Unit& u) const {
        const long L = (long)i * G + c; if (L >= nwg) return false;
        int wgid = (int)L; { const int q = nwg / NXCD, r = nwg % NXCD, xcd = wgid % NXCD, off = wgid / NXCD; wgid = (xcd < r ? xcd * (q + 1) : r * (q + 1) + (xcd - r) * q) + off; }
        const int nig = WGM * nN, gid = wgid / nig, fm = gid * WGM, gsz = (nM - fm) < WGM ? (nM - fm) : WGM;
        u.pm = fm + ((wgid % nig) % gsz); u.pn = (wgid % nig) / gsz; return true;
    }
    __device__ __forceinline__ void a_ready(const Unit&) const {}
    __device__ __forceinline__ void done(const Unit&) const {}
};

struct SplitOrder {
    StaticOrder base; int G, c, nwg, nshort0, light, heavy; bool split;
    __host__ __device__ void init(int M, int N, int G_, int c_, int n_first) {
        base.init(M, N, 1, 0); G = G_; c = c_; nwg = base.nwg; nshort0 = n_first % G_; light = 1; heavy = 3;
        split = (nshort0 > 0) && (nshort0 * light + (G_ - nshort0) * heavy == nwg);
    }
    __host__ __device__ bool next(int i, Unit& u) const {
        long L;
        if (split) { if (c < nshort0) { if (i >= light) return false; L = (long)c * light + i; } else { if (i >= heavy) return false; L = (long)nshort0 * light + (long)(c - nshort0) * heavy + i; } }
        else L = (long)i * G + c;
        if (L >= nwg) return false;
        return base.next((int)L, u);
    }
    __device__ __forceinline__ void a_ready(const Unit&) const {}
    __device__ __forceinline__ void done(const Unit&) const {}
};

__device__ __forceinline__ unsigned cvt_pk_bf16(float lo, float hi) { unsigned r; asm volatile("v_cvt_pk_bf16_f32 %0, %1, %2" : "=v"(r) : "v"(lo), "v"(hi)); return r; }
typedef unsigned u32x2 __attribute__((ext_vector_type(2)));
template <bool I8> struct EpiZ {
    static constexpr bool PERM = true, AFTER_DRAIN = false;
    bf16_t* Z; const float* rope; float* out; int layer; const float* hs; const float* wsc;
    __device__ __forceinline__ void operator()(const f32x4 (&acc)[2][2][4][2], const Unit& u, int wr, int wc, int fr, int fq) const {
        const int pn = I8 ? map8(u.pn) : map16(u.pn), b = u.pm >> 3, rbase = u.pm * BM + wr * 64 + fr, cl = wc * 32 + 8 * fq;
        f32x4 cs[2][2];
        if (I8) {
#pragma unroll
            for (int bj = 0; bj < 2; ++bj)
#pragma unroll
                for (int n = 0; n < 2; ++n) cs[bj][n] = *(const f32x4*)(wsc + u.pn * BM + bj * HALF + cl + 4 * n) * QS;
        }
        const int type = pn < 4 ? 0 : pn < 10 ? 1 : pn < 16 ? 2 : pn < 22 ? 3 : pn < 24 ? 4 : pn < 26 ? 5 : 6;
#pragma unroll
        for (int ai = 0; ai < 2; ++ai)
#pragma unroll
            for (int m = 0; m < 4; ++m) {
                const int r = rbase + ai * HALF + m * 16, t = r & 2047;
                bf16_t* zrow = Z + (size_t)r * DIN;
                float rs = 1.0f; if (I8) rs = hs[r];
#pragma unroll
                for (int bj = 0; bj < 2; ++bj) {
                    f32x4 v0 = acc[ai][bj][m][0], v1 = acc[ai][bj][m][1];
                    if (I8) { const i32x4_t a0 = __builtin_bit_cast(i32x4_t, v0), a1 = __builtin_bit_cast(i32x4_t, v1);
#pragma unroll
                        for (int i = 0; i < 4; ++i) { v0[i] = (float)a0[i] * (rs * cs[bj][0][i]); v1[i] = (float)a1[i] * (rs * cs[bj][1][i]); } }
                    const int cpos = pn * BM + bj * HALF;
                    if (type == 0) {
                        const int ch = ((cpos + cl) >> 3) * 4;
                        f32x4 uu;
#pragma unroll
                        for (int i = 0; i < 4; ++i) uu[i] = v0[i] / (1.0f + __expf(-v1[i]));
                        u32x2 w; w.x = cvt_pk_bf16(uu[0], uu[1]); w.y = cvt_pk_bf16(uu[2], uu[3]);
                        *(u32x2*)(zrow + ch) = w;
                        if (t >= SEQ - 30) *(f32x4*)(out + O_CP + ((size_t)((layer * NB + b) * 30 + t - (SEQ - 30))) * WA + ch) = uu;
                    } else if (type == 1 || type == 2 || type == 4 || type == 5) {
                        const int i0 = 16 * wc + 4 * fq;
                        const f32x4 cs0 = *(const f32x4*)(rope + ((size_t)t * 64 + i0) * 2), cs1 = *(const f32x4*)(rope + ((size_t)t * 64 + i0) * 2 + 4);
                        const f32x4 c = (f32x4){cs0[0], cs0[2], cs1[0], cs1[2]}, s = (f32x4){cs0[1], cs0[3], cs1[1], cs1[3]};
                        f32x4 o1 = v0 * c - v1 * s, o2 = v1 * c + v0 * s;
                        float sc = 1.0f;
                        if (type == 1) sc = SQ_ATT;
                        if (type == 4) { const int h = (cpos - OFF_QC) >> 7; sc = __builtin_amdgcn_exp2f((float)(t & 127) * lg2_gamma(h)); }
                        if (type == 5) { const int h = (cpos - OFF_KC) >> 7; sc = KS_RET * __builtin_amdgcn_exp2f(-(float)(t & 127) * lg2_gamma(h)); }
                        o1 = o1 * sc; o2 = o2 * sc;
                        u32x2 w; w.x = cvt_pk_bf16(o1[0], o1[1]); w.y = cvt_pk_bf16(o1[2], o1[3]);
                        *(u32x2*)(zrow + cpos + i0) = w;
                        w.x = cvt_pk_bf16(o2[0], o2[1]); w.y = cvt_pk_bf16(o2[2], o2[3]);
                        *(u32x2*)(zrow + cpos + 64 + i0) = w;
                        if (type == 2) {
                            const int g = (cpos - OFF_KB) >> 9, hh = ((cpos - OFF_KB) >> 7) & 3, L = 128 << (2 * g);
                            const size_t wb = (g == 0 ? O_W1P : g == 1 ? O_W2P : O_W3P);
                            if (t >= SEQ - L) { float* o = out + wb + ((size_t)((layer * NB + b) * L + t - (SEQ - L)) * 2 + 0) * 512 + hh * 128 + i0; *(f32x4*)o = o1; *(f32x4*)(o + 64) = o2; }
                        }
                    } else {
                        u32x4 w; w.x = cvt_pk_bf16(v0[0], v0[1]); w.y = cvt_pk_bf16(v0[2], v0[3]); w.z = cvt_pk_bf16(v1[0], v1[1]); w.w = cvt_pk_bf16(v1[2], v1[3]);
                        *(u32x4*)(zrow + cpos + cl) = w;
                        if (type == 3) {
                            const int g = (cpos - OFF_VB) >> 9, hh = ((cpos - OFF_VB) >> 7) & 3, L = 128 << (2 * g);
                            const size_t wb = (g == 0 ? O_W1P : g == 1 ? O_W2P : O_W3P);
                            if (t >= SEQ - L) { float* o = out + wb + ((size_t)((layer * NB + b) * L + t - (SEQ - L)) * 2 + 1) * 512 + hh * 128 + cl; *(f32x4*)o = v0; *(f32x4*)(o + 4) = v1; }
                        }
                    }
                }
            }
    }
};
struct EpiRes {
    static constexpr bool PERM = false, AFTER_DRAIN = false;
    const float* xsrc; float* X; const float* gate; float wscale;
    __device__ __forceinline__ void operator()(const f32x4 (&acc)[2][2][4][2], const Unit& u, int wr, int wc, int fr, int fq) const {
        const int b = u.pm >> 3, col0 = u.pn * BM + wc * 32 + 4 * fq, row0 = u.pm * BM + wr * 64 + fr;
        f32x4 gv[2][2];
#pragma unroll
        for (int bj = 0; bj < 2; ++bj)
#pragma unroll
            for (int n = 0; n < 2; ++n) gv[bj][n] = *(const f32x4*)(gate + (size_t)b * 12288 + col0 + bj * HALF + n * 16) * wscale;
#pragma unroll
        for (int ai = 0; ai < 2; ++ai)
#pragma unroll
            for (int m = 0; m < 4; ++m) { const size_t off = (size_t)(row0 + ai * HALF + m * 16) * DM + col0;
#pragma unroll
                for (int bj = 0; bj < 2; ++bj)
#pragma unroll
                    for (int n = 0; n < 2; ++n) { const f32x4 xs = *(const f32x4*)(xsrc + off + bj * HALF + n * 16);
                        *(f32x4*)(X + off + bj * HALF + n * 16) = xs * ALPHA + gv[bj][n] * acc[ai][bj][m][n]; } }
    }
};
__device__ __forceinline__ unsigned e4m3x2(float a, float b) { return (unsigned)__builtin_amdgcn_cvt_pk_fp8_f32(fminf(a, 448.f), fminf(b, 448.f), 0, false) & 0xffffu; }
struct EpiUp {
    static constexpr bool PERM = true, AFTER_DRAIN = false;
    unsigned char* O; const float* hs; const float* wsc;
    __device__ __forceinline__ void operator()(const f32x4 (&acc)[2][2][4][2], const Unit& u, int wr, int wc, int fr, int fq) const {
        const int row0 = u.pm * BM + wr * 64 + fr, col0 = u.pn * BM + wc * 32 + 8 * fq;
        f32x4 cs[2][2];
#pragma unroll
        for (int bj = 0; bj < 2; ++bj)
#pragma unroll
            for (int n = 0; n < 2; ++n) cs[bj][n] = *(const f32x4*)(wsc + col0 + bj * HALF + 4 * n) * QS;
#pragma unroll
        for (int ai = 0; ai < 2; ++ai)
#pragma unroll
            for (int m = 0; m < 4; ++m) { const int r = row0 + ai * HALF + m * 16; unsigned char* rowp = O + (size_t)r * DFF + col0; const float rs = hs[r];
#pragma unroll
                for (int bj = 0; bj < 2; ++bj) { const i32x4_t a0 = __builtin_bit_cast(i32x4_t, acc[ai][bj][m][0]), a1 = __builtin_bit_cast(i32x4_t, acc[ai][bj][m][1]); f32x4 v0, v1;
#pragma unroll
                    for (int i = 0; i < 4; ++i) { const float a = fmaxf((float)a0[i] * (rs * cs[bj][0][i]), 0.f), c = fmaxf((float)a1[i] * (rs * cs[bj][1][i]), 0.f); v0[i] = a * a; v1[i] = c * c; }
                    u32x2 w; w.x = e4m3x2(v0[0], v0[1]) | (e4m3x2(v0[2], v0[3]) << 16); w.y = e4m3x2(v1[0], v1[1]) | (e4m3x2(v1[2], v1[3]) << 16);
                    *(u32x2*)(rowp + bj * HALF) = w; } }
    }
};
template <class Epi, class Sched, bool ALIGN_EPI = false, bool SP2 = false, int OPK = 0>
__device__ __forceinline__ void gemm_phase(PG8_LAS unsigned char* lds, const Gemm g, const Sched& S, const Epi& E) {
    constexpr bool FP8 = (OPK == 1), I8 = (OPK == 2);
    int tid_op = (int)threadIdx.x; asm volatile("" : "+v"(tid_op));
    const int tid = tid_op, wid = __builtin_amdgcn_readfirstlane(tid >> 6), lane = tid & 63, wr = wid >> 2, wc = wid & 3, fr = lane & 15, fq = lane >> 4;
    const int K = g.K, nt = K / BK;
    unsigned voffA[2], voffB[2];
#pragma unroll
    for (int i = 0; i < 2; ++i) { int R, C; stage_rc(tid * 16 + i * 8192, R, C); const int Rb = Epi::PERM ? ((R & ~31) + perm32(R & 31)) : R;
        voffA[i] = (unsigned)(R * K + C) * 2u; voffB[i] = (unsigned)(Rb * K + C) * 2u; }
    const size_t kstep = (size_t)(BK * 2);
    const size_t hstep = (size_t)HALF * K * 2;
    const size_t tstep = 2 * hstep;
    const unsigned ldsw = (unsigned)wid * 1024u;
    const int aoff = lds_byte(wr * 64 + fr, fq * 8), boff = lds_byte(wc * 32 + fr, fq * 8);
#define PG8_SA(b, h) (((b) * 2 + (h)) * HTB)
#define PG8_SB(b, h) ((4 + (b) * 2 + (h)) * HTB)
#define PG8_STAGE(bufoff, gbase, voff) do { _Pragma("unroll") for (int _i = 0; _i < 2; ++_i) \
        __builtin_amdgcn_global_load_lds((const unsigned*)((const char*)(gbase) + (voff)[_i]), (PG8_LAS unsigned*)(lds + (bufoff) + ldsw + _i * 8192), 16, 0, 0); } while (0)
#define PG8_LDA(dst, b, h) do { _Pragma("unroll") for (int m = 0; m < 4; ++m) _Pragma("unroll") for (int k = 0; k < 2; ++k) dst[m][k] = *(const PG8_LAS bf16x8*)(lds + PG8_SA(b, h) + aoff + m * 2048 + k * 1024); } while (0)
#define PG8_LDB(dst, b, h) do { _Pragma("unroll") for (int n = 0; n < 2; ++n) _Pragma("unroll") for (int k = 0; k < 2; ++k) dst[n][k] = *(const PG8_LAS bf16x8*)(lds + PG8_SB(b, h) + boff + n * 2048 + k * 1024); } while (0)
#define PG8_CAT8(x0, x1) __builtin_shufflevector(__builtin_bit_cast(i32x4_t, x0), __builtin_bit_cast(i32x4_t, x1), 0, 1, 2, 3, 4, 5, 6, 7)
#define PG8_MMA(ai, bj, At, Bt) do { __builtin_amdgcn_s_setprio(1); \
        if constexpr (FP8) { _Pragma("unroll") for (int m = 0; m < 4; ++m) _Pragma("unroll") for (int n = 0; n < 2; ++n) \
            asm volatile("v_mfma_scale_f32_16x16x128_f8f6f4 %0, %1, %2, %0, %3, %3 op_sel_hi:[0,0,0]" : "+v"(acc[ai][bj][m][n]) : "v"(PG8_CAT8(Bt[n][0], Bt[n][1])), "v"(PG8_CAT8(At[m][0], At[m][1])), "v"(fp8_unit_scale)); } \
        else if constexpr (I8) { _Pragma("unroll") for (int m = 0; m < 4; ++m) _Pragma("unroll") for (int n = 0; n < 2; ++n) _Pragma("unroll") for (int k = 0; k < 2; ++k) \
            acc[ai][bj][m][n] = __builtin_bit_cast(f32x4, __builtin_amdgcn_mfma_i32_16x16x64_i8(__builtin_bit_cast(i32x4_t, Bt[n][k]), __builtin_bit_cast(i32x4_t, At[m][k]), __builtin_bit_cast(i32x4_t, acc[ai][bj][m][n]), 0, 0, 0)); } \
        else { _Pragma("unroll") for (int m = 0; m < 4; ++m) _Pragma("unroll") for (int n = 0; n < 2; ++n) _Pragma("unroll") for (int k = 0; k < 2; ++k) \
            acc[ai][bj][m][n] = __builtin_amdgcn_mfma_f32_16x16x32_bf16(Bt[n][k], At[m][k], acc[ai][bj][m][n], 0, 0, 0); } __builtin_amdgcn_s_setprio(0); } while (0)
#define PG8_WAIT_V(n) asm volatile("s_waitcnt vmcnt(" #n ")" ::: "memory")
#define PG8_WAIT_L(n) asm volatile("s_waitcnt lgkmcnt(" #n ")" ::: "memory")
#define PG8_BAR __builtin_amdgcn_s_barrier()
#define PG8_SCHED __builtin_amdgcn_sched_barrier(0)
    Unit cur, nxt; int ui = 0;
    if (!S.next(0, cur)) return;
    f32x4 acc[2][2][4][2];
#pragma unroll
    for (int a = 0; a < 2; ++a)
#pragma unroll
        for (int b = 0; b < 2; ++b)
#pragma unroll
            for (int m = 0; m < 4; ++m)
#pragma unroll
                for (int n = 0; n < 2; ++n) acc[a][b][m][n] = (f32x4){0.f, 0.f, 0.f, 0.f};
    bf16x8 At[4][2], B0[2][2], B1[2][2];
    const int fp8_unit_scale = 0x7f7f7f7f; (void)fp8_unit_scale;
    const char* cA = (const char*)g.A + (size_t)cur.pm * tstep; const char* cB = (const char*)g.Bt + (size_t)cur.pn * tstep;
    S.a_ready(cur);
    if constexpr (SP2) {
        PG8_STAGE(PG8_SB(0, 0), cB, voffB); PG8_STAGE(PG8_SB(0, 1), cB + hstep, voffB); PG8_STAGE(PG8_SA(0, 0), cA, voffA); PG8_STAGE(PG8_SA(0, 1), cA + hstep, voffA);
        if (wr == 1) PG8_BAR;
        PG8_WAIT_V(2); PG8_BAR;
        PG8_STAGE(PG8_SB(1, 0), cB + kstep, voffB); PG8_STAGE(PG8_SA(1, 0), cA + kstep, voffA); PG8_STAGE(PG8_SB(1, 1), cB + hstep + kstep, voffB);
        PG8_WAIT_V(6); PG8_BAR;
    } else {
        PG8_STAGE(PG8_SB(0, 0), cB, voffB); PG8_STAGE(PG8_SA(0, 0), cA, voffA); PG8_STAGE(PG8_SB(0, 1), cB + hstep, voffB); PG8_STAGE(PG8_SA(0, 1), cA + hstep, voffA);
        if (wr == 1) PG8_BAR;
        PG8_WAIT_V(4); PG8_BAR;
        PG8_STAGE(PG8_SB(1, 0), cB + kstep, voffB); PG8_STAGE(PG8_SA(1, 0), cA + kstep, voffA); PG8_STAGE(PG8_SB(1, 1), cB + hstep + kstep, voffB);
        PG8_WAIT_V(6); PG8_BAR;
    }
    for (;;) {
        const bool has_next = S.next(ui + 1, nxt);
        const char* nA = has_next ? (const char*)g.A + (size_t)nxt.pm * tstep : cA; const char* nB = has_next ? (const char*)g.Bt + (size_t)nxt.pn * tstep : cB;
        for (int t = 0; t < nt; t += 2) {
            const bool last = (t == nt - 2);
            const char* a1 = cA + (size_t)(t + 1) * kstep;
            const char* a2 = last ? nA : cA + (size_t)(t + 2) * kstep; const char* b2 = last ? nB : cB + (size_t)(t + 2) * kstep;
            const char* a3 = a2 + kstep; const char* b3 = b2 + kstep;
            if (last && has_next) S.a_ready(nxt);
            if constexpr (SP2) {
            PG8_LDB(B0, 0, 0); PG8_LDB(B1, 0, 1); PG8_SCHED; PG8_LDA(At, 0, 0); PG8_STAGE(PG8_SA(1, 1), a1 + hstep, voffA);
            PG8_WAIT_V(8); PG8_WAIT_L(0); PG8_BAR; PG8_MMA(0, 0, At, B0); PG8_MMA(0, 1, At, B1); PG8_BAR; PG8_SCHED;
            PG8_LDA(At, 0, 1); PG8_STAGE(PG8_SB(0, 0), b2, voffB); PG8_STAGE(PG8_SB(0, 1), b2 + hstep, voffB); PG8_STAGE(PG8_SA(0, 0), a2, voffA);
            PG8_WAIT_V(8); PG8_WAIT_L(0); PG8_BAR; PG8_MMA(1, 0, At, B0); PG8_MMA(1, 1, At, B1); PG8_BAR; PG8_SCHED;
            PG8_LDB(B0, 1, 0); PG8_LDB(B1, 1, 1); PG8_SCHED; PG8_LDA(At, 1, 0); PG8_STAGE(PG8_SA(0, 1), a2 + hstep, voffA);
            PG8_WAIT_V(8); PG8_WAIT_L(0); PG8_BAR; PG8_MMA(0, 0, At, B0); PG8_MMA(0, 1, At, B1); PG8_BAR; PG8_SCHED;
            PG8_LDA(At, 1, 1); PG8_STAGE(PG8_SB(1, 0), b3, voffB); PG8_STAGE(PG8_SB(1, 1), b3 + hstep, voffB); PG8_STAGE(PG8_SA(1, 0), a3, voffA);
            PG8_WAIT_V(8); PG8_WAIT_L(0); PG8_BAR; PG8_MMA(1, 0, At, B0); PG8_MMA(1, 1, At, B1); PG8_BAR; PG8_SCHED;
            } else {
            PG8_LDB(B0, 0, 0); PG8_SCHED; PG8_LDA(At, 0, 0); PG8_STAGE(PG8_SA(1, 1), a1 + hstep, voffA);
            PG8_WAIT_L(8); PG8_BAR; PG8_WAIT_L(0); PG8_MMA(0, 0, At, B0); PG8_BAR; PG8_SCHED;
            PG8_LDB(B1, 0, 1); PG8_STAGE(PG8_SB(0, 0), b2, voffB);
            PG8_BAR; PG8_WAIT_L(0); PG8_MMA(0, 1, At, B1); PG8_BAR;
            PG8_LDA(At, 0, 1); PG8_STAGE(PG8_SA(0, 0), a2, voffA);
            PG8_BAR; PG8_WAIT_L(0); PG8_MMA(1, 0, At, B0); PG8_BAR; PG8_SCHED;
            PG8_STAGE(PG8_SB(0, 1), b2 + hstep, voffB);
            PG8_WAIT_V(6); PG8_BAR; PG8_MMA(1, 1, At, B1); PG8_BAR;
            PG8_LDB(B0, 1, 0); PG8_SCHED; PG8_LDA(At, 1, 0); PG8_STAGE(PG8_SA(0, 1), a2 + hstep, voffA);
            PG8_WAIT_L(8); PG8_BAR; PG8_WAIT_L(0); PG8_MMA(0, 0, At, B0); PG8_BAR; PG8_SCHED;
            PG8_LDB(B1, 1, 1); PG8_STAGE(PG8_SB(1, 0), b3, voffB);
            PG8_BAR; PG8_WAIT_L(0); PG8_MMA(0, 1, At, B1); PG8_BAR;
            PG8_LDA(At, 1, 1); PG8_STAGE(PG8_SA(1, 0), a3, voffA);
            PG8_BAR; PG8_WAIT_L(0); PG8_MMA(1, 0, At, B0); PG8_BAR; PG8_SCHED;
            PG8_STAGE(PG8_SB(1, 1), b3 + hstep, voffB);
            PG8_WAIT_V(6); PG8_BAR; PG8_MMA(1, 1, At, B1); PG8_BAR;
            }
        }
        if constexpr (FP8) { asm volatile("s_nop 15\n\ts_nop 15" ::: "memory"); }
        if constexpr (ALIGN_EPI) { if (wr == 0) PG8_BAR; }
        if constexpr (!Epi::AFTER_DRAIN) { E(acc, cur, wr, wc, fr, fq); S.done(cur); }
        if (!has_next) break;
#pragma unroll
        for (int a = 0; a < 2; ++a)
#pragma unroll
            for (int b = 0; b < 2; ++b)
#pragma unroll
                for (int m = 0; m < 4; ++m)
#pragma unroll
                    for (int n = 0; n < 2; ++n) acc[a][b][m][n] = (f32x4){0.f, 0.f, 0.f, 0.f};
        cur = nxt; cA = nA; cB = nB; ++ui;
        if constexpr (ALIGN_EPI) { if (wr == 1) PG8_BAR; }
    }
    PG8_WAIT_V(0);
    if constexpr (!ALIGN_EPI) { if (wr == 0) PG8_BAR; }
    PG8_BAR;
    if constexpr (Epi::AFTER_DRAIN) { E.fused(acc, cur, wr, wc, fr, fq, lds, wid, lane); S.done(cur); }
#undef PG8_SA
#undef PG8_SB
#undef PG8_STAGE
#undef PG8_LDA
#undef PG8_LDB
#undef PG8_MMA
#undef PG8_CAT8
#undef PG8_WAIT_V
#undef PG8_WAIT_L
#undef PG8_BAR
#undef PG8_SCHED
}
}
#define GAS __attribute__((address_space(1)))
#define LAS __attribute__((address_space(3)))
typedef unsigned short bf16;
typedef unsigned v4u __attribute__((ext_vector_type(4)));
typedef unsigned v2u __attribute__((ext_vector_type(2)));
typedef float f32x4 __attribute__((ext_vector_type(4)));
typedef float f32x2 __attribute__((ext_vector_type(2)));
typedef short bf16x8 __attribute__((ext_vector_type(8)));
typedef short s16x4 __attribute__((ext_vector_type(4)));
typedef GAS unsigned gu32;
#define RLX_AGENT __ATOMIC_RELAXED, __HIP_MEMORY_SCOPE_AGENT
#define LDS_WAIT() asm volatile("s_waitcnt lgkmcnt(0)" ::: "memory")
#define VM_WAIT() asm volatile("s_waitcnt vmcnt(0)" ::: "memory")
__device__ __forceinline__ unsigned f2bf(float f) { unsigned u = __builtin_bit_cast(unsigned, f); return (u + 0x7fffu + ((u >> 16) & 1u)) >> 16; }
__device__ __forceinline__ unsigned pk2(float lo, float hi) { return f2bf(lo) | (f2bf(hi) << 16); }
__device__ __forceinline__ float bf2f(unsigned short v) { return __builtin_bit_cast(float, (unsigned)v << 16); }
__device__ __forceinline__ float bflo(unsigned w) { return __builtin_bit_cast(float, w << 16); }
__device__ __forceinline__ float bfhi(unsigned w) { return __builtin_bit_cast(float, w & 0xffff0000u); }
__device__ __forceinline__ float wave_sum(float v) {
#pragma unroll
    for (int o = 1; o < 64; o <<= 1) v += __shfl_xor(v, o);
    return v;
}
__device__ __forceinline__ float wave_max(float v) {
#pragma unroll
    for (int o = 1; o < 64; o <<= 1) v = fmaxf(v, __shfl_xor(v, o));
    return v;
}
__device__ __forceinline__ float silu_f(float v) { return v / (1.0f + __expf(-v)); }
__device__ __forceinline__ float sigm_f(float v) { return 1.0f / (1.0f + __expf(-v)); }
__device__ __forceinline__ bf16x8 tr8(LAS const unsigned char* img, int pitch, int r0a, int r0b, int c0, int lane) {
    const int q = (lane & 15) >> 2, p = lane & 3;
    const s16x4 lo = __builtin_bit_cast(s16x4, __builtin_amdgcn_ds_read_tr16_b64_v4i16((LAS s16x4*)(img + (r0a + q) * pitch + (c0 + 4 * p) * 2)));
    const s16x4 hi = __builtin_bit_cast(s16x4, __builtin_amdgcn_ds_read_tr16_b64_v4i16((LAS s16x4*)(img + (r0b + q) * pitch + (c0 + 4 * p) * 2)));
    return (bf16x8){lo[0], lo[1], lo[2], lo[3], hi[0], hi[1], hi[2], hi[3]};
}
__device__ __forceinline__ bf16x8 pack8(f32x4 a, f32x4 b) {
    v4u w; w.x = pk2(a[0], a[1]); w.y = pk2(a[2], a[3]); w.z = pk2(b[0], b[1]); w.w = pk2(b[2], b[3]);
    return __builtin_bit_cast(bf16x8, w);
}
#define MFMA16(a, b, c) __builtin_amdgcn_mfma_f32_16x16x32_bf16((a), (b), (c), 0, 0, 0)
__host__ __device__ __forceinline__ int perm_in(int n) {
    if (n < 1024) { const int q = n >> 3, s = n & 7; return s < 4 ? 4 * q + s : 512 + 4 * q + (s - 4); }
    if ((n >= OFF_QB && n < OFF_VB) || (n >= OFF_QC && n < OFF_VC)) { const int hb = n & ~127, p = n & 127, q = p >> 3, s = p & 7; return hb + (s < 4 ? 4 * q + s : 64 + 4 * q + (s - 4)); }
    return n;
}
__device__ __forceinline__ unsigned fp8x2(float a, float b) {
    a = fminf(fmaxf(a, -448.f), 448.f); b = fminf(fmaxf(b, -448.f), 448.f);
    return (unsigned)__builtin_amdgcn_cvt_pk_fp8_f32(a, b, 0, false) & 0xffffu;
}
typedef int v8i_t __attribute__((ext_vector_type(8)));
typedef int v4i_t __attribute__((ext_vector_type(4)));
#define MFMA8(a, b, c) __builtin_amdgcn_mfma_scale_f32_16x16x128_f8f6f4((a), (b), (c), 0, 0, 0, 0x7f7f7f7f, 0, 0x7f7f7f7f)
constexpr float WDN_SCALE = 1024.0f;
__device__ __forceinline__ unsigned q8x4(float a, float b, float c, float d, float inv) {
    const int ia = (int)fminf(fmaxf(rintf(a * inv), -127.f), 127.f), ib = (int)fminf(fmaxf(rintf(b * inv), -127.f), 127.f), ic = (int)fminf(fmaxf(rintf(c * inv), -127.f), 127.f), id = (int)fminf(fmaxf(rintf(d * inv), -127.f), 127.f);
    return (unsigned)(ia & 0xff) | ((unsigned)(ib & 0xff) << 8) | ((unsigned)(ic & 0xff) << 16) | ((unsigned)(id & 0xff) << 24);
}
#define MFMAI8(a, b, c) __builtin_amdgcn_mfma_i32_16x16x64_i8((a), (b), (c), 0, 0, 0)
#define XB_TMO      128
#define XB_XCNT(j)  (256  + 64 * (j))
#define XB_XSUB(j)  (1280 + 64 * (j))
#define XB_XGEN(j)  (2304 + 64 * (j))
#define XB_TOP      3328
#define XB_TOPGEN   3392
#define XCD_BAR_WORDS 3456
#define XB_SPIN_CAP (1u << 18)

__device__ __forceinline__ unsigned xb_ld(unsigned* p)              { return __hip_atomic_load(p, __ATOMIC_RELAXED, __HIP_MEMORY_SCOPE_AGENT); }
__device__ __forceinline__ unsigned xb_add(unsigned* p, unsigned v) { return __hip_atomic_fetch_add(p, v, __ATOMIC_RELAXED, __HIP_MEMORY_SCOPE_AGENT); }
__device__ __forceinline__ unsigned xb_xcc_id() { return (unsigned)__builtin_amdgcn_s_getreg((3 << 11) | 20) & 0xFu; }
#define XB_SPIN(cond, bar) do { unsigned _sp = 0; while (cond) { __builtin_amdgcn_s_sleep(1); \
    if ((++_sp & 255u) == 0u) { if (xb_ld(&(bar)[XB_TMO])) break; if (_sp > XB_SPIN_CAP) { atomicAdd(&(bar)[XB_TMO], 1u); break; } } } } while (0)

struct XcdBarrier {
    unsigned* bar; unsigned x;
    volatile LAS unsigned* st;
};

__device__ __forceinline__ XcdBarrier xcd_barrier_post(unsigned* bar, volatile LAS unsigned* st) {
    XcdBarrier b; b.bar = bar; b.x = xb_xcc_id(); b.st = st;
    if (threadIdx.x == 0) (void)xb_add(&bar[XB_XCNT(b.x)], 1u);
    return b;
}
__device__ __forceinline__ void xcd_barrier_complete(unsigned* bar, unsigned x, unsigned& nloc, unsigned& nx) {
    const unsigned G = gridDim.x * gridDim.y * gridDim.z;
    unsigned sum, cnt, mine, sp = 0u;
    for (;;) {
        sum = 0u; cnt = 0u; mine = 0u;
#pragma unroll
        for (unsigned j = 0; j < 16; ++j) { const unsigned c = xb_ld(&bar[XB_XCNT(j)]); sum += c; cnt += (c > 0u) ? 1u : 0u; mine = (j == x) ? c : mine; }
        if (sum == G) break;
        __builtin_amdgcn_s_sleep(1);
        if ((++sp & 255u) == 0u) { if (xb_ld(&bar[XB_TMO])) break; if (sp > XB_SPIN_CAP) { atomicAdd(&bar[XB_TMO], 1u); break; } }
    }
    nloc = mine > 0u ? mine : 1u; nx = cnt > 0u ? cnt : 1u;
}

__device__ __forceinline__ void xcd_barrier(const XcdBarrier& b) {
    asm volatile("s_waitcnt vmcnt(0)" ::: "memory");
    __syncthreads();
    if (threadIdx.x == 0) {
        unsigned* bar = b.bar;
        __builtin_amdgcn_s_waitcnt(0);
        unsigned nloc = b.st[0], nx = b.st[1];
        if (nloc == 0u) { xcd_barrier_complete(bar, b.x, nloc, nx); b.st[0] = nloc; b.st[1] = nx; }
        const unsigned old = xb_add(&bar[XB_XSUB(b.x)], 1u);
        const unsigned gen = old / nloc;
        if (old + 1u == (gen + 1u) * nloc) {
            __builtin_amdgcn_fence(__ATOMIC_RELEASE, "agent");
            asm volatile("s_waitcnt vmcnt(0)" ::: "memory");
            const unsigned og = xb_add(&bar[XB_TOP], 1u);
            const unsigned tg = og / nx;
            if (og + 1u == (tg + 1u) * nx) xb_add(&bar[XB_TOPGEN], 1u);
            else XB_SPIN(xb_ld(&bar[XB_TOPGEN]) == tg, bar);
            __builtin_amdgcn_fence(__ATOMIC_ACQUIRE, "agent");
            xb_add(&bar[XB_XGEN(b.x)], 1u);
            asm volatile("s_waitcnt vmcnt(0)" ::: "memory");
        } else {
            XB_SPIN(xb_ld(&bar[XB_XGEN(b.x)]) == gen, bar);
            __builtin_amdgcn_fence(__ATOMIC_ACQUIRE, "agent");
            asm volatile("s_waitcnt vmcnt(0)" ::: "memory");
        }
    }
    __syncthreads();
}
struct Ctx { LAS unsigned char* lds; int wave, bid, G; };
#define TID tid_
#define LANE lane_
__device__ __forceinline__ int opaque_tid() { int t = (int)threadIdx.x; asm volatile("" : "+v"(t)); return t; }
#define DECL_TID const int tid_ = opaque_tid(); const int lane_ = tid_ & 63; (void)lane_;

__device__ __forceinline__ void phase_mod(const Ctx& C, const float* cP, const float* cS, const float* w_ada, const float* b_ada, float* mod, float* rope, const float* w_up, unsigned* amax_up, const float* w_in, unsigned* amax_in) {
    DECL_TID
    for (int i = C.bid * NTHR + TID; i < 2052 * 64; i += C.G * NTHR) {
        const int p = i >> 6, f = i & 63;
        const double inv = exp2(-(double)f * (13.287712379549449 / 64.0));
        const double ang = (double)(p < 2048 ? p : PAST + p - 2048) * inv;
        double s, c; sincos(ang, &s, &c);
        rope[2 * i] = (float)c; rope[2 * i + 1] = (float)s;
    }
    LAS float* scs = (LAS float*)C.lds;
    LAS float* red = (LAS float*)(C.lds + 98304);
    for (int i = TID; i < 12 * 2048; i += NTHR) { const int r = i >> 11, k = i & 2047; const float v = r < 4 ? cP[r * 2048 + k] : cS[(r - 4) * 2048 + k]; scs[i] = silu_f(v); }
    __syncthreads();
    for (int u = C.bid; u < 704; u += C.G) {
        if (u < 256) {
            const int l = u >> 6, n0 = (u & 63) * 192;
            const float* wp = w_ada + ((size_t)l * 2048 + C.wave * 256) * 12288 + n0;
            float a0[12], a1[12], a2[12];
#pragma unroll
            for (int r = 0; r < 12; ++r) { a0[r] = 0.f; a1[r] = 0.f; a2[r] = 0.f; }
#pragma unroll 2
            for (int k = 0; k < 256; k += 4) {
                f32x2 wa[4]; float wb[4];
#pragma unroll
                for (int j = 0; j < 4; ++j) { wa[j] = *(const f32x2*)(wp + (size_t)(k + j) * 12288 + 2 * LANE); wb[j] = wp[(size_t)(k + j) * 12288 + 128 + LANE]; }
#pragma unroll
                for (int r = 0; r < 12; ++r) { const f32x4 s = *(const LAS f32x4*)(scs + r * 2048 + C.wave * 256 + k);
                    a0[r] += (s[0] * wa[0][0] + s[1] * wa[1][0]) + (s[2] * wa[2][0] + s[3] * wa[3][0]);
                    a1[r] += (s[0] * wa[0][1] + s[1] * wa[1][1]) + (s[2] * wa[2][1] + s[3] * wa[3][1]);
                    a2[r] += (s[0] * wb[0] + s[1] * wb[1]) + (s[2] * wb[2] + s[3] * wb[3]); }
            }
#pragma unroll
            for (int hf = 0; hf < 2; ++hf) {
#pragma unroll
                for (int r = 0; r < 6; ++r) { LAS float* rr = red + (C.wave * 6 + r) * 192; rr[2 * LANE] = a0[6 * hf + r]; rr[2 * LANE + 1] = a1[6 * hf + r]; rr[128 + LANE] = a2[6 * hf + r]; }
                __syncthreads();
                for (int i = TID; i < 6 * 192; i += NTHR) { const int r = i / 192, c = i % 192; float s = 0.f;
#pragma unroll
                    for (int w = 0; w < 8; ++w) s += red[(w * 6 + r) * 192 + c];
                    mod[((size_t)l * 12 + 6 * hf + r) * 12288 + n0 + c] = s + b_ada[l * 12288 + n0 + c]; }
                __syncthreads();
            }
        } else {
            const bool up = u < 512; const int v = up ? u - 256 : u - 512;
            int l, n0, krows; const float* wp; size_t ldw; unsigned* dst;
            if (up) { l = v >> 6; n0 = ((v >> 1) & 31) * 256; krows = 128; ldw = DFF; wp = w_up + ((size_t)l * DM + (v & 1) * 1024 + C.wave * 128) * DFF + n0 + 4 * LANE; dst = amax_up + l * DFF + n0; }
            else { l = v / 48; const int t = v % 48; n0 = (t >> 2) * 256; krows = 64; ldw = DIN; wp = w_in + ((size_t)l * DM + (t & 3) * 512 + C.wave * 64) * DIN + perm_in(pos8(n0 + 4 * LANE)); dst = amax_in + l * NIN8 + n0; }
            f32x4 m = (f32x4){0.f, 0.f, 0.f, 0.f};
#pragma unroll 8
            for (int k = 0; k < krows; ++k) { const f32x4 w = *(const f32x4*)(wp + (size_t)k * ldw); m[0] = fmaxf(m[0], fabsf(w[0])); m[1] = fmaxf(m[1], fabsf(w[1])); m[2] = fmaxf(m[2], fabsf(w[2])); m[3] = fmaxf(m[3], fabsf(w[3])); }
            *(LAS f32x4*)(red + C.wave * 256 + 4 * LANE) = m;
            __syncthreads();
            if (TID < 256) { float mm = 0.f;
#pragma unroll
                for (int w = 0; w < 8; ++w) mm = fmaxf(mm, red[w * 256 + TID]);
                atomicMax(dst + TID, __builtin_bit_cast(unsigned, mm)); }
            __syncthreads();
        }
    }
}

__device__ __forceinline__ void transpose_item(const float* W, int K, int N, int ldw, bf16* WT, bool perm, LAS float* scr, int item, int lane) {
    const int nblk = N / 32, kb = item / nblk, nb = item % nblk, k0 = 64 * kb, n0 = 32 * nb;
    const int srcc = perm ? perm_in(pos16(n0 + (lane & 31))) : n0 + (lane & 31);
    { float t[32];
#pragma unroll
      for (int i = 0; i < 32; ++i) t[i] = W[(size_t)(k0 + 2 * i + (lane >> 5)) * ldw + srcc];
#pragma unroll
      for (int i = 0; i < 32; ++i) scr[(2 * i + (lane >> 5)) * 33 + (lane & 31)] = t[i]; }
    LDS_WAIT(); asm volatile("" ::: "memory");
    const int c = lane & 7;
#pragma unroll
    for (int j = 0; j < 4; ++j) { const int n = (lane >> 3) + 8 * j; const LAS float* s = scr + (8 * c) * 33 + n;
        v4u o; o.x = pk2(s[0 * 33], s[1 * 33]); o.y = pk2(s[2 * 33], s[3 * 33]); o.z = pk2(s[4 * 33], s[5 * 33]); o.w = pk2(s[6 * 33], s[7 * 33]);
        *(v4u*)(WT + (size_t)(n0 + n) * K + k0 + 8 * c) = o; }
    LDS_WAIT(); asm volatile("" ::: "memory");
}
__device__ __forceinline__ void transpose_item_fp8(const float* W, int K, int N, unsigned char* WT8, float scale, LAS float* scr, int item, int lane) {
    const int nblk = N / 32, kb = item / nblk, nb = item % nblk, k0 = 128 * kb, n0 = 32 * nb;
#pragma unroll
    for (int hh = 0; hh < 2; ++hh) { float t[32];
#pragma unroll
      for (int i = 0; i < 32; ++i) t[i] = W[(size_t)(k0 + 64 * hh + 2 * i + (lane >> 5)) * N + n0 + (lane & 31)];
#pragma unroll
      for (int i = 0; i < 32; ++i) scr[(64 * hh + 2 * i + (lane >> 5)) * 33 + (lane & 31)] = t[i]; }
    LDS_WAIT(); asm volatile("" ::: "memory");
    const int n = lane & 31, kc = lane >> 5; const LAS float* s = scr + (64 * kc) * 33 + n;
    unsigned char* dst = WT8 + (size_t)(n0 + n) * K + k0 + 64 * kc;
#pragma unroll
    for (int j = 0; j < 4; ++j) { v4u o;
        o.x = fp8x2(s[(16 * j + 0) * 33] * scale, s[(16 * j + 1) * 33] * scale) | (fp8x2(s[(16 * j + 2) * 33] * scale, s[(16 * j + 3) * 33] * scale) << 16);
        o.y = fp8x2(s[(16 * j + 4) * 33] * scale, s[(16 * j + 5) * 33] * scale) | (fp8x2(s[(16 * j + 6) * 33] * scale, s[(16 * j + 7) * 33] * scale) << 16);
        o.z = fp8x2(s[(16 * j + 8) * 33] * scale, s[(16 * j + 9) * 33] * scale) | (fp8x2(s[(16 * j + 10) * 33] * scale, s[(16 * j + 11) * 33] * scale) << 16);
        o.w = fp8x2(s[(16 * j + 12) * 33] * scale, s[(16 * j + 13) * 33] * scale) | (fp8x2(s[(16 * j + 14) * 33] * scale, s[(16 * j + 15) * 33] * scale) << 16);
        *(v4u*)(dst + 16 * j) = o; }
    LDS_WAIT(); asm volatile("" ::: "memory");
}
__device__ __forceinline__ void transpose_item_i8(const float* W, int K, int N, int ldw, bool perm, unsigned char* WT8, const float* wsc, LAS float* scr, int item, int lane) {
    const int nblk = N / 32, kb = item / nblk, nb = item % nblk, k0 = 128 * kb, n0 = 32 * nb;
    const int srcc = perm ? perm_in(pos8(n0 + (lane & 31))) : n0 + (lane & 31);
#pragma unroll
    for (int hh = 0; hh < 2; ++hh) { float t[32];
#pragma unroll
      for (int i = 0; i < 32; ++i) t[i] = W[(size_t)(k0 + 64 * hh + 2 * i + (lane >> 5)) * ldw + srcc];
#pragma unroll
      for (int i = 0; i < 32; ++i) scr[(64 * hh + 2 * i + (lane >> 5)) * 33 + (lane & 31)] = t[i]; }
    LDS_WAIT(); asm volatile("" ::: "memory");
    const int n = lane & 31, kc = lane >> 5; const LAS float* s = scr + (64 * kc) * 33 + n;
    const float sc = wsc[n0 + n] * QS, inv = sc > 0.f ? 1.0f / sc : 0.f;
    unsigned char* dst = WT8 + (size_t)(n0 + n) * K + k0 + 64 * kc;
#pragma unroll
    for (int j = 0; j < 4; ++j) { v4u o;
        o.x = q8x4(s[(16 * j + 0) * 33], s[(16 * j + 1) * 33], s[(16 * j + 2) * 33], s[(16 * j + 3) * 33], inv);
        o.y = q8x4(s[(16 * j + 4) * 33], s[(16 * j + 5) * 33], s[(16 * j + 6) * 33], s[(16 * j + 7) * 33], inv);
        o.z = q8x4(s[(16 * j + 8) * 33], s[(16 * j + 9) * 33], s[(16 * j + 10) * 33], s[(16 * j + 11) * 33], inv);
        o.w = q8x4(s[(16 * j + 12) * 33], s[(16 * j + 13) * 33], s[(16 * j + 14) * 33], s[(16 * j + 15) * 33], inv);
        *(v4u*)(dst + 16 * j) = o; }
    LDS_WAIT(); asm volatile("" ::: "memory");
}
__device__ __forceinline__ void modulate_row_bf16(const float* xrow, const float* sc, const float* sh, bf16* hrow, int lane) {
#pragma unroll
    for (int j = 0; j < 8; ++j) { const int c = 4 * lane + 256 * j; const f32x4 x = *(const f32x4*)(xrow + c), a = *(const f32x4*)(sc + c), d = *(const f32x4*)(sh + c);
        const f32x4 h = x * (a + 1.0f) + d; v2u w; w.x = pk2(h[0], h[1]); w.y = pk2(h[2], h[3]); *(v2u*)(hrow + c) = w; }
}
__device__ __forceinline__ void phase_prep(const Ctx& C, const float* const* in, float* out, unsigned char* ws) {
    DECL_TID
    LAS float* scr = (LAS float*)(C.lds + C.wave * 17408);
    const int gw = C.bid * NWAVES + C.wave, NGW = C.G * NWAVES;
    constexpr int I_IN = (DM / 64) * (NIN16 / 32), I_IN8 = (DM / 128) * (NIN8 / 32), I_O = (DM / 64) * (DM / 32), I_UP = (DM / 128) * (DFF / 32), I_DN = (DFF / 128) * (DM / 32), I_L = I_IN + I_IN8 + I_O + I_UP + I_DN;
    constexpr int N_CONV = DEPTH * I_L, N_WROW = DEPTH * NBS * (124 + 508 + 2044), N_CROW = DEPTH * NBS * 26, N_ALL = N_CONV + N_WROW + N_CROW + MT;
    const float* mod = (const float*)(ws + WS_MOD);
    for (int it = gw; it < N_ALL; it += NGW) {
        int r = it;
        if (r < N_CONV) {
            const int l = r / I_L; r -= l * I_L;
            if (r < I_IN) { transpose_item(in[11] + (size_t)l * DM * DIN, DM, NIN16, DIN, (bf16*)(ws + WS_WIN) + (size_t)l * NIN16 * DM, true, scr, r, LANE); continue; } r -= I_IN;
            if (r < I_IN8) { transpose_item_i8(in[11] + (size_t)l * DM * DIN, DM, NIN8, DIN, true, ws + WS_WIN8 + (size_t)l * NIN8 * DM, (const float*)(ws + WS_CTL) + CW_AMAX_IN + l * NIN8, scr, r, LANE); continue; } r -= I_IN8;
            if (r < I_O) { transpose_item(in[16] + (size_t)l * DM * DM, DM, DM, DM, (bf16*)(ws + WS_WO) + (size_t)l * DM * DM, false, scr, r, LANE); continue; } r -= I_O;
            if (r < I_UP) { transpose_item_i8(in[19] + (size_t)l * DM * DFF, DM, DFF, DFF, false, ws + WS_WUP + (size_t)l * DFF * DM, (const float*)(ws + WS_CTL) + CW_AMAX_UP + l * DFF, scr, r, LANE); continue; } r -= I_UP;
            transpose_item_fp8(in[20] + (size_t)l * DFF * DM, DFF, DM, ws + WS_WDN + (size_t)l * DM * DFF, WDN_SCALE, scr, r, LANE); continue;
        }
        r -= N_CONV;
        if (r < N_WROW) {
            const int lb = r / 2676, j = r % 2676; int g, row; if (j < 124) { g = 0; row = j; } else if (j < 632) { g = 1; row = j - 124; } else { g = 2; row = j - 632; }
            const int L = 128 << (2 * g);
            const float* src = (g == 0 ? in[3] : g == 1 ? in[4] : in[5]) + ((size_t)lb * L + row + 4) * 1024;
            float* dst = out + (g == 0 ? O_W1S : g == 1 ? O_W2S : O_W3S) + ((size_t)lb * L + row) * 1024;
#pragma unroll
            for (int j4 = 0; j4 < 4; ++j4) *(f32x4*)(dst + 4 * LANE + 256 * j4) = *(const f32x4*)(src + 4 * LANE + 256 * j4);
            continue;
        }
        r -= N_WROW;
        if (r < N_CROW) {
            const int lb = r / 26, row = r % 26;
            const float* src = in[2] + ((size_t)lb * 30 + row + 4) * WA; float* dst = out + O_CS + ((size_t)lb * 30 + row) * WA;
#pragma unroll
            for (int j4 = 0; j4 < 2; ++j4) *(f32x4*)(dst + 4 * LANE + 256 * j4) = *(const f32x4*)(src + 4 * LANE + 256 * j4);
            continue;
        }
        r -= N_CROW;
        {
            const float* xrow = r < MP ? in[0] + (size_t)r * DM : in[1] + (size_t)(r - MP) * DM;
            const int rb = r < MP ? (r >> 11) : 4 + ((r - MP) >> 2);
            const float* mrow = mod + (size_t)rb * 12288;
            f32x4 hv[8];
#pragma unroll
            for (int j = 0; j < 8; ++j) { const int c = 4 * LANE + 256 * j; hv[j] = *(const f32x4*)(xrow + c) * (*(const f32x4*)(mrow + 2048 + c) + 1.0f) + *(const f32x4*)(mrow + c);
                v2u w; w.x = pk2(hv[j][0], hv[j][1]); w.y = pk2(hv[j][2], hv[j][3]); *(v2u*)((bf16*)(ws + WS_H) + (size_t)r * DM + c) = w; }
            float am = 0.f;
#pragma unroll
            for (int j = 0; j < 8; ++j) am = fmaxf(am, fmaxf(fmaxf(fabsf(hv[j][0]), fabsf(hv[j][1])), fmaxf(fabsf(hv[j][2]), fabsf(hv[j][3]))));
            am = wave_max(am);
            const float inv = am > 0.f ? 127.0f / am : 0.f;
#pragma unroll
            for (int j = 0; j < 8; ++j) *(unsigned*)(ws + WS_H8 + (size_t)r * DM + 4 * LANE + 256 * j) = q8x4(hv[j][0], hv[j][1], hv[j][2], hv[j][3], inv);
            if (LANE == 0) ((float*)(ws + WS_HSC))[r] = am * (1.0f / 127.0f);
        }
    }
}

__device__ __forceinline__ void ln_load(int l, int which, const float* const* in, unsigned char* ws, int r, int lane, f32x4 (&v)[8]) {
    const float* X = (const float*)(ws + WS_X); const float* mod = (const float*)(ws + WS_MOD); const float* TSr = (const float*)(ws + WS_TS);
    if (r < MP) {
#pragma unroll
        for (int j = 0; j < 8; ++j) v[j] = *(const f32x4*)(X + (size_t)r * DM + 4 * lane + 256 * j);
    } else {
        const int rb = 4 + ((r - MP) >> 2);
        const float* xs = (l == 0 && which == 1) ? in[1] + (size_t)(r - MP) * DM : X + (size_t)r * DM;
        const float* gt = mod + ((size_t)l * 12 + rb) * 12288 + (which == 1 ? 2 : 5) * 2048; const float* tr = TSr + (size_t)(r - MP) * DM;
#pragma unroll
        for (int j = 0; j < 8; ++j) { const int c = 4 * lane + 256 * j; v[j] = *(const f32x4*)(xs + c) * ALPHA + *(const f32x4*)(gt + c) * *(const f32x4*)(tr + c); }
    }
}
__device__ __forceinline__ void ln_finish(int l, int which, const float* const* in, float* out, unsigned char* ws, bool dummy, int r, int lane, f32x4 (&v)[8]) {
    const float* mod = (const float*)(ws + WS_MOD);
    const float* gam = (which == 1 ? in[17] : in[21]) + (size_t)l * DM; const float* bet = (which == 1 ? in[18] : in[22]) + (size_t)l * DM;
    const bool last = (l == DEPTH - 1 && which == 2);
    const int rb = r < MP ? (r >> 11) : 4 + ((r - MP) >> 2);
    float s = 0.f;
#pragma unroll
    for (int j = 0; j < 8; ++j) s += (v[j][0] + v[j][1]) + (v[j][2] + v[j][3]);
    const float mean = wave_sum(s) * (1.0f / DM); float s2 = 0.f;
#pragma unroll
    for (int j = 0; j < 8; ++j) { v[j] = v[j] - mean; s2 += (v[j][0] * v[j][0] + v[j][1] * v[j][1]) + (v[j][2] * v[j][2] + v[j][3] * v[j][3]); }
    const float rstd = 1.0f / sqrtf(wave_sum(s2) * (1.0f / DM) + LN_EPS);
    float* XW = (float*)(ws + (dummy ? WS_X2 : WS_X));
    float* dst = (last && !dummy) ? (r < MP ? out + O_YP + (size_t)r * DM : out + O_YS + (size_t)(r - MP) * DM) : XW + (size_t)r * DM;
    const float* mrow = which == 1 ? mod + ((size_t)l * 12 + rb) * 12288 + 3 * 2048 : mod + ((size_t)(last ? l : l + 1) * 12 + rb) * 12288;
    bf16* H = (bf16*)(ws + (dummy ? WS_H2 : WS_H));
#pragma unroll
    for (int j = 0; j < 8; ++j) { const int c = 4 * lane + 256 * j;
        const f32x4 y = v[j] * rstd * *(const f32x4*)(gam + c) + *(const f32x4*)(bet + c);
        *(f32x4*)(dst + c) = y;
        if (!last) { const f32x4 h = y * (*(const f32x4*)(mrow + 2048 + c) + 1.0f) + *(const f32x4*)(mrow + c); v[j] = h;
            if (which == 2) { v2u w; w.x = pk2(h[0], h[1]); w.y = pk2(h[2], h[3]); *(v2u*)(H + (size_t)r * DM + c) = w; } } }
    if (!last) {
        float am = 0.f;
#pragma unroll
        for (int j = 0; j < 8; ++j) am = fmaxf(am, fmaxf(fmaxf(fabsf(v[j][0]), fabsf(v[j][1])), fmaxf(fabsf(v[j][2]), fabsf(v[j][3]))));
        am = wave_max(am);
        const float inv = am > 0.f ? 127.0f / am : 0.f;
        unsigned char* h8 = ws + (dummy ? WS_H2 + 17 * MiB : WS_H8) + (size_t)r * DM;
#pragma unroll
        for (int j = 0; j < 8; ++j) *(unsigned*)(h8 + 4 * lane + 256 * j) = q8x4(v[j][0], v[j][1], v[j][2], v[j][3], inv);
        if (lane == 0 && !dummy) ((float*)(ws + WS_HSC))[r] = am * (1.0f / 127.0f);
    }
}
__device__ __forceinline__ void phase_ln(const Ctx& C, int l, int which, const float* const* in, float* out, unsigned char* ws, bool dummy) {
    DECL_TID
    const int gw = C.bid * NWAVES + C.wave, NGW = C.G * NWAVES;
    for (int r = gw; r < MT; r += 2 * NGW) {
        const int r2 = r + NGW;
        f32x4 va[8], vb[8];
        ln_load(l, which, in, ws, r, LANE, va);
        if (r2 < MT) ln_load(l, which, in, ws, r2, LANE, vb);
        ln_finish(l, which, in, out, ws, dummy, r, LANE, va);
        if (r2 < MT) ln_finish(l, which, in, out, ws, dummy, r2, LANE, vb);
    }
}

template <int MODE>
__device__ __forceinline__ void mini_gemm(const Ctx& C, const bf16* A, int lda, const bf16* Bt, int N, int K, void* outp, int ldo) {
    DECL_TID
    const int fr = LANE & 15, fq = LANE >> 4, kw = K / 8;
    LAS float* red = (LAS float*)C.lds;
    for (int u = C.bid; u < N / 16; u += C.G) {
        f32x4 acc0 = (f32x4){0.f, 0.f, 0.f, 0.f}, acc1 = acc0;
        const bf16* bp = Bt + (size_t)(16 * u + fr) * K + C.wave * kw + 8 * fq;
        const bf16* ap0 = A + (size_t)fr * lda + C.wave * kw + 8 * fq; const bf16* ap1 = ap0 + (size_t)16 * lda;
#pragma unroll 8
        for (int k = 0; k < kw; k += 32) {
            const bf16x8 b = *(const bf16x8*)(bp + k), a0 = *(const bf16x8*)(ap0 + k), a1 = *(const bf16x8*)(ap1 + k);
            acc0 = MFMA16(a0, b, acc0); acc1 = MFMA16(a1, b, acc1);
        }
        *(LAS f32x4*)(red + ((C.wave * 2 + 0) * 64 + LANE) * 4) = acc0;
        *(LAS f32x4*)(red + ((C.wave * 2 + 1) * 64 + LANE) * 4) = acc1;
        __syncthreads();
        { const int rt = TID >> 8, ln = (TID >> 2) & 63, i = TID & 3; float s = 0.f;
#pragma unroll
          for (int w = 0; w < 8; ++w) s += red[((w * 2 + rt) * 64 + ln) * 4 + i];
          const int row = 16 * rt + 4 * (ln >> 4) + i, col = 16 * u + (ln & 15);
          if (MODE == 0) ((float*)outp)[(size_t)row * ldo + perm_in(pos16(col))] = s;
          else if (MODE == 1) ((float*)outp)[(size_t)row * ldo + col] = s;
          else { const float rl = fmaxf(s, 0.f); ((unsigned char*)outp)[(size_t)row * ldo + col] = (unsigned char)(fp8x2(rl * rl, 0.f) & 0xffu); } }
        __syncthreads();
    }
}

__device__ __forceinline__ void mini_gemm_fp8(const Ctx& C, const unsigned char* A, int lda, const unsigned char* Bt, int N, int K, float* outp, int ldo, float oscale) {
    DECL_TID
    const int fr = LANE & 15, fq = LANE >> 4, kw = K / 8;
    LAS float* red = (LAS float*)C.lds;
    for (int u = C.bid; u < N / 16; u += C.G) {
        f32x4 acc0 = (f32x4){0.f, 0.f, 0.f, 0.f}, acc1 = acc0;
        const unsigned char* bp = Bt + (size_t)(16 * u + fr) * K + C.wave * kw + 32 * fq;
        const unsigned char* ap0 = A + (size_t)fr * lda + C.wave * kw + 32 * fq; const unsigned char* ap1 = ap0 + (size_t)16 * lda;
#pragma unroll 4
        for (int k = 0; k < kw; k += 128) {
            const v8i_t b = __builtin_shufflevector(*(const v4i_t*)(bp + k), *(const v4i_t*)(bp + k + 16), 0, 1, 2, 3, 4, 5, 6, 7);
            const v8i_t a0 = __builtin_shufflevector(*(const v4i_t*)(ap0 + k), *(const v4i_t*)(ap0 + k + 16), 0, 1, 2, 3, 4, 5, 6, 7);
            const v8i_t a1 = __builtin_shufflevector(*(const v4i_t*)(ap1 + k), *(const v4i_t*)(ap1 + k + 16), 0, 1, 2, 3, 4, 5, 6, 7);
            acc0 = MFMA8(a0, b, acc0); acc1 = MFMA8(a1, b, acc1);
        }
        *(LAS f32x4*)(red + ((C.wave * 2 + 0) * 64 + LANE) * 4) = acc0;
        *(LAS f32x4*)(red + ((C.wave * 2 + 1) * 64 + LANE) * 4) = acc1;
        __syncthreads();
        { const int rt = TID >> 8, ln = (TID >> 2) & 63, i = TID & 3; float s = 0.f;
#pragma unroll
          for (int w = 0; w < 8; ++w) s += red[((w * 2 + rt) * 64 + ln) * 4 + i];
          const int row = 16 * rt + 4 * (ln >> 4) + i, col = 16 * u + (ln & 15);
          outp[(size_t)row * ldo + col] = s * oscale; }
        __syncthreads();
    }
}

template <int MODE>
__device__ __forceinline__ void mini_gemm_i8(const Ctx& C, const unsigned char* A, int lda, const float* hs, const unsigned char* Bt, const float* wsc, int N, int K, void* outp, int ldo) {
    DECL_TID
    const int fr = LANE & 15, fq = LANE >> 4, kw = K / 8;
    LAS int* red = (LAS int*)C.lds;
    for (int u = C.bid; u < N / 16; u += C.G) {
        v4i_t acc0 = (v4i_t){0, 0, 0, 0}, acc1 = acc0;
        const unsigned char* bp = Bt + (size_t)(16 * u + fr) * K + C.wave * kw + 16 * fq;
        const unsigned char* ap0 = A + (size_t)fr * lda + C.wave * kw + 16 * fq; const unsigned char* ap1 = ap0 + (size_t)16 * lda;
#pragma unroll
        for (int k = 0; k < kw; k += 64) {
            const v4i_t b = *(const v4i_t*)(bp + k), a0 = *(const v4i_t*)(ap0 + k), a1 = *(const v4i_t*)(ap1 + k);
            acc0 = MFMAI8(a0, b, acc0); acc1 = MFMAI8(a1, b, acc1);
        }
        *(LAS v4i_t*)(red + ((C.wave * 2 + 0) * 64 + LANE) * 4) = acc0;
        *(LAS v4i_t*)(red + ((C.wave * 2 + 1) * 64 + LANE) * 4) = acc1;
        __syncthreads();
        { const int rt = TID >> 8, ln = (TID >> 2) & 63, i = TID & 3; int s = 0;
#pragma unroll
          for (int w = 0; w < 8; ++w) s += red[((w * 2 + rt) * 64 + ln) * 4 + i];
          const int row = 16 * rt + 4 * (ln >> 4) + i, col = 16 * u + (ln & 15);
          const float val = (float)s * (hs[row] * (wsc[col] * QS));
          if (MODE == 0) { const float rl = fmaxf(val, 0.f); ((unsigned char*)outp)[(size_t)row * ldo + col] = (unsigned char)(fp8x2(rl * rl, 0.f) & 0xffu); }
          else ((float*)outp)[(size_t)row * ldo + perm_in(pos8(col))] = val; }
        __syncthreads();
    }
}

__device__ __forceinline__ void attn_unit(const Ctx& C, int uidx, const bf16* Z, bf16* ATTO, float* ATTL) {
    DECL_TID
    const int i16 = uidx & 15, rest = uidx >> 4, g = rest % 3, bh = rest / 3, h = bh & 3, b = bh >> 2;
    const int dil = 1 << (2 * g), r = i16 & (dil - 1), qblk = i16 >> (2 * g);
    const int fr = LANE & 15, fq = LANE >> 4, wave = C.wave;
    constexpr int PK = 272;
    LAS unsigned char* Kimg = C.lds; LAS unsigned char* Vimg = C.lds + 128 * PK;
    const size_t rs = (size_t)dil * DIN;
    const bf16* zb = Z + ((size_t)b * SEQ + r) * DIN;
    const int qc = OFF_QB + g * 512 + h * 128, kc = OFF_KB + g * 512 + h * 128, vc = OFF_VB + g * 512 + h * 128;
    const int m0 = qblk * 128, qi = 16 * wave + fr;
    bf16x8 qf[4];
    { const bf16* qp = zb + (size_t)(m0 + qi) * rs + qc + 8 * fq;
#pragma unroll
      for (int s = 0; s < 4; ++s) qf[s] = *(const bf16x8*)(qp + 32 * s); }
    float mrun = -1e30f, lrun = 0.f; f32x4 o[8];
#pragma unroll
    for (int dt = 0; dt < 8; ++dt) o[dt] = (f32x4){0.f, 0.f, 0.f, 0.f};
    for (int blk = (qblk > 0 ? 0 : 1); blk < 2; ++blk) {
        const int kb0 = m0 - 128 + blk * 128;
        __syncthreads();
#pragma unroll
        for (int i = 0; i < 4; ++i) { const int c = TID + NTHR * i, row = c >> 4, ch = c & 15; const bf16* src = zb + (size_t)(kb0 + row) * rs;
            const v4u kv = *(const v4u*)(src + kc + ch * 8), vv = *(const v4u*)(src + vc + ch * 8);
            *(LAS v4u*)(Kimg + row * PK + ch * 16) = kv; *(LAS v4u*)(Vimg + row * PK + ch * 16) = vv; }
        __syncthreads();
        const int kt_lo = blk == 0 ? wave : 0, kt_hi = blk == 0 ? 7 : wave;
        f32x4 sreg[8];
#pragma unroll
        for (int kt = 0; kt < 8; ++kt) {
            f32x4 acc = (f32x4){-1e30f, -1e30f, -1e30f, -1e30f};
            if (kt >= kt_lo && kt <= kt_hi) {
                acc = (f32x4){0.f, 0.f, 0.f, 0.f};
#pragma unroll
                for (int s = 0; s < 4; ++s) { const bf16x8 a = *(const LAS bf16x8*)(Kimg + (16 * kt + fr) * PK + (32 * s + 8 * fq) * 2); acc = MFMA16(a, qf[s], acc); }
#pragma unroll
                for (int i = 0; i < 4; ++i) { const int j = 16 * kt + 4 * fq + i; const bool ok = blk == 0 ? (j >= qi) : (j <= qi); acc[i] = ok ? acc[i] : -1e30f; }
            }
            sreg[kt] = acc;
        }
        float mx = -1e30f;
#pragma unroll
        for (int kt = 0; kt < 8; ++kt) mx = fmaxf(fmaxf(mx, fmaxf(sreg[kt][0], sreg[kt][1])), fmaxf(sreg[kt][2], sreg[kt][3]));
        mx = fmaxf(mx, __shfl_xor(mx, 16)); mx = fmaxf(mx, __shfl_xor(mx, 32));
        const float mnew = fmaxf(mrun, mx), corr = __builtin_amdgcn_exp2f(mrun - mnew);
        float ps = 0.f;
#pragma unroll
        for (int kt = 0; kt < 8; ++kt)
#pragma unroll
            for (int i = 0; i < 4; ++i) { const float p = __builtin_amdgcn_exp2f(sreg[kt][i] - mnew); sreg[kt][i] = p; ps += p; }
        ps += __shfl_xor(ps, 16); ps += __shfl_xor(ps, 32);
        lrun = lrun * corr + ps; mrun = mnew;
#pragma unroll
        for (int dt = 0; dt < 8; ++dt) o[dt] = o[dt] * corr;
#pragma unroll
        for (int s2 = 0; s2 < 4; ++s2) {
            if (2 * s2 + 1 >= kt_lo && 2 * s2 <= kt_hi) {
                const bf16x8 pb = pack8(sreg[2 * s2], sreg[2 * s2 + 1]);
#pragma unroll
                for (int dt = 0; dt < 8; ++dt) { const bf16x8 va = tr8(Vimg, PK, 32 * s2 + 4 * fq, 32 * s2 + 16 + 4 * fq, 16 * dt, LANE); o[dt] = MFMA16(va, pb, o[dt]); }
            }
        }
    }
    const float inv = 1.0f / lrun;
    const size_t row = (size_t)b * SEQ + (size_t)(m0 + qi) * dil + r;
    bf16* op = ATTO + ((size_t)g * MP + row) * 512 + h * 128 + 4 * fq;
#pragma unroll
    for (int dt = 0; dt < 8; ++dt) { v2u w; w.x = pk2(o[dt][0] * inv, o[dt][1] * inv); w.y = pk2(o[dt][2] * inv, o[dt][3] * inv); *(v2u*)(op + 16 * dt) = w; }
    if (fq == 0) ATTL[((size_t)g * MP + row) * 4 + h] = mrun + __builtin_amdgcn_logf(lrun);
}

__device__ __forceinline__ void ret_scan_unit(const Ctx& C, int uidx, int l, const bf16* Z, bf16* SPREV, float* out) {
    DECL_TID
    const int sl = uidx & 7, bh = uidx >> 3, h = bh & 3, b = bh >> 2;
    const int fr = LANE & 15, fq = LANE >> 4, wave = C.wave;
    constexpr int PK = 272, PS = 80;
    LAS unsigned char* Kimg = C.lds; LAS unsigned char* Vimg = C.lds + 128 * PK;
    const bf16* zb = Z + (size_t)b * SEQ * DIN;
    const int dvt = wave & 1, dk0 = (wave >> 1) * 2;
    const float lg = lg2_gamma(h), g128 = __builtin_amdgcn_exp2f(128.0f * lg), g127 = __builtin_amdgcn_exp2f(127.0f * lg);
    f32x4 S[2];
    S[0] = (f32x4){0.f, 0.f, 0.f, 0.f}; S[1] = S[0];
    v4u kreg[4], vreg;
    { const bf16* zr = zb;
#pragma unroll
      for (int i = 0; i < 4; ++i) { const int q = TID + NTHR * i, row = q >> 4, ch = q & 15; kreg[i] = *(const v4u*)(zr + (size_t)row * DIN + OFF_KC + h * 128 + ch * 8); }
      { const int row = TID >> 2, ch = TID & 3; vreg = *(const v4u*)(zr + (size_t)row * DIN + OFF_VC + h * 256 + sl * 32 + ch * 8); } }
    for (int c = 0; c < NCH; ++c) {
        __syncthreads();
#pragma unroll
        for (int i = 0; i < 4; ++i) { const int q = TID + NTHR * i, row = q >> 4, ch = q & 15; *(LAS v4u*)(Kimg + row * PK + ch * 16) = kreg[i]; }
        { const int row = TID >> 2, ch = TID & 3; *(LAS v4u*)(Vimg + row * PS + ch * 16) = vreg; }
        __syncthreads();
        if (c + 1 < NCH) { const bf16* zr = zb + (size_t)(c + 1) * 128 * DIN;
#pragma unroll
            for (int i = 0; i < 4; ++i) { const int q = TID + NTHR * i, row = q >> 4, ch = q & 15; kreg[i] = *(const v4u*)(zr + (size_t)row * DIN + OFF_KC + h * 128 + ch * 8); }
            { const int row = TID >> 2, ch = TID & 3; vreg = *(const v4u*)(zr + (size_t)row * DIN + OFF_VC + h * 256 + sl * 32 + ch * 8); } }
        bf16* sp = SPREV + ((size_t)bh * NCH + c) * 32768 + sl * 32 + 16 * dvt + 4 * fq;
#pragma unroll
        for (int j = 0; j < 2; ++j) { v2u w; w.x = pk2(S[j][0], S[j][1]); w.y = pk2(S[j][2], S[j][3]); *(v2u*)(sp + (size_t)(16 * (dk0 + j) + fr) * 256) = w; }
        f32x4 kv[2]; kv[0] = (f32x4){0.f, 0.f, 0.f, 0.f}; kv[1] = kv[0];
#pragma unroll
        for (int s = 0; s < 4; ++s) { const int m0 = 32 * s + 8 * fq;
            const bf16x8 a = tr8(Vimg, PS, m0, m0 + 4, 16 * dvt, LANE);
#pragma unroll
            for (int j = 0; j < 2; ++j) { const bf16x8 bk = tr8(Kimg, PK, m0, m0 + 4, 16 * (dk0 + j), LANE); kv[j] = MFMA16(a, bk, kv[j]); } }
#pragma unroll
        for (int j = 0; j < 2; ++j) S[j] = S[j] * g128 + kv[j] * g127;
    }
    float* o = out + O_RP + ((size_t)l * 16 + bh) * 32768 + sl * 32 + 16 * dvt + 4 * fq;
#pragma unroll
    for (int j = 0; j < 2; ++j) *(f32x4*)(o + (size_t)(16 * (dk0 + j) + fr) * 256) = S[j];
}

__device__ __forceinline__ void conv_unit(const Ctx& C, int uidx, int l, const bf16* Z, bf16* Y, const float* const* in) {
    DECL_TID
    const int b = uidx >> 6, t0 = (uidx & 63) * 32;
    LAS bf16* Uimg = (LAS bf16*)C.lds;
    LAS float* Cimg = (LAS float*)(C.lds + 63488);
    __syncthreads();
    for (int q = TID; q < 62 * 64; q += NTHR) { const int j = q >> 6, ch = q & 63, t = t0 - 30 + j;
        v4u v = (v4u){0u, 0u, 0u, 0u}; if (t >= 0) v = *(const v4u*)(Z + ((size_t)b * SEQ + t) * DIN + ch * 8);
        *(LAS v4u*)(Uimg + j * 512 + ch * 8) = v; }
    __syncthreads();
    { const int ch = TID; float w[31], uw[62];
      const float* cw = in[12] + (size_t)l * CONVK * WA + ch;
#pragma unroll
      for (int j = 0; j < 31; ++j) w[j] = cw[j * WA];
#pragma unroll
      for (int j = 0; j < 62; ++j) uw[j] = bf2f(Uimg[j * 512 + ch]);
      const float bias = in[13][l * WA + ch];
#pragma unroll
      for (int i = 0; i < 32; ++i) { float a = bias;
#pragma unroll
          for (int j = 0; j < 31; ++j) a += w[j] * uw[i + j];
          Cimg[i * 512 + ch] = a; } }
    __syncthreads();
    const float* lg = in[14] + (size_t)l * WA + 8 * LANE; const float* lb = in[15] + (size_t)l * WA + 8 * LANE;
#pragma unroll
    for (int k = 0; k < 4; ++k) { const int i = 4 * C.wave + k;
        const f32x4 v0 = *(const LAS f32x4*)(Cimg + i * 512 + 8 * LANE), v1 = *(const LAS f32x4*)(Cimg + i * 512 + 8 * LANE + 4);
        const float mean = wave_sum((v0[0] + v0[1]) + (v0[2] + v0[3]) + (v1[0] + v1[1]) + (v1[2] + v1[3])) * (1.0f / WA);
        const f32x4 d0 = v0 - mean, d1 = v1 - mean;
        const float var = wave_sum((d0[0] * d0[0] + d0[1] * d0[1]) + (d0[2] * d0[2] + d0[3] * d0[3]) + (d1[0] * d1[0] + d1[1] * d1[1]) + (d1[2] * d1[2] + d1[3] * d1[3])) * (1.0f / WA);
        const float rstd = 1.0f / sqrtf(var + LN_EPS);
        const f32x4 y0 = d0 * rstd * *(const f32x4*)lg + *(const f32x4*)lb, y1 = d1 * rstd * *(const f32x4*)(lg + 4) + *(const f32x4*)(lb + 4);
        v4u w; w.x = pk2(silu_f(y0[0]), silu_f(y0[1])); w.y = pk2(silu_f(y0[2]), silu_f(y0[3])); w.z = pk2(silu_f(y1[0]), silu_f(y1[1])); w.w = pk2(silu_f(y1[2]), silu_f(y1[3]));
        *(v4u*)(Y + ((size_t)b * SEQ + t0 + i) * DM + 8 * LANE) = w; }
}

__device__ __forceinline__ void conv_s_unit(const Ctx& C, int b, int l, const float* ZS, bf16* Y, const float* const* in, float* out) {
    DECL_TID
    LAS float* Cimg = (LAS float*)C.lds;
    __syncthreads();
    { const int ch = TID; float ue[34], w[31];
#pragma unroll
      for (int j = 0; j < 30; ++j) ue[j] = in[2][((size_t)(l * NBS + b) * 30 + j) * WA + ch];
#pragma unroll
      for (int t = 0; t < 4; ++t) { const float* zr = ZS + (size_t)(b * 4 + t) * DIN; ue[30 + t] = zr[OFF_A + ch] * sigm_f(zr[OFF_GA + ch]);
          out[O_CS + ((size_t)(l * NBS + b) * 30 + 26 + t) * WA + ch] = ue[30 + t]; }
      const float* cw = in[12] + (size_t)l * CONVK * WA + ch;
#pragma unroll
      for (int j = 0; j < 31; ++j) w[j] = cw[j * WA];
      const float bias = in[13][l * WA + ch];
#pragma unroll
      for (int t = 0; t < 4; ++t) { float a = bias;
#pragma unroll
          for (int j = 0; j < 31; ++j) a += w[j] * ue[t + j];
          Cimg[t * 512 + ch] = a; } }
    __syncthreads();
    if (C.wave < 4) { const int t = C.wave;
        const float* lg = in[14] + (size_t)l * WA + 8 * LANE; const float* lb = in[15] + (size_t)l * WA + 8 * LANE;
        const f32x4 v0 = *(const LAS f32x4*)(Cimg + t * 512 + 8 * LANE), v1 = *(const LAS f32x4*)(Cimg + t * 512 + 8 * LANE + 4);
        const float mean = wave_sum((v0[0] + v0[1]) + (v0[2] + v0[3]) + (v1[0] + v1[1]) + (v1[2] + v1[3])) * (1.0f / WA);
        const f32x4 d0 = v0 - mean, d1 = v1 - mean;
        const float var = wave_sum((d0[0] * d0[0] + d0[1] * d0[1]) + (d0[2] * d0[2] + d0[3] * d0[3]) + (d1[0] * d1[0] + d1[1] * d1[1]) + (d1[2] * d1[2] + d1[3] * d1[3])) * (1.0f / WA);
        const float rstd = 1.0f / sqrtf(var + LN_EPS);
        const f32x4 y0 = d0 * rstd * *(const f32x4*)lg + *(const f32x4*)lb, y1 = d1 * rstd * *(const f32x4*)(lg + 4) + *(const f32x4*)(lb + 4);
        v4u w; w.x = pk2(silu_f(y0[0]), silu_f(y0[1])); w.y = pk2(silu_f(y0[2]), silu_f(y0[3])); w.z = pk2(silu_f(y1[0]), silu_f(y1[1])); w.w = pk2(silu_f(y1[2]), silu_f(y1[3]));
        *(v4u*)(Y + ((size_t)MP + b * 4 + t) * DM + 8 * LANE) = w; }
}

__device__ __forceinline__ void attn_s_unit(const Ctx& C, int uidx, int l, const float* ZS, const float* rope, bf16* Y, const float* const* in, float* out) {
    DECL_TID
    const int t = uidx & 3, h = (uidx >> 2) & 3, b = uidx >> 4;
    LAS float* qrot = (LAS float*)C.lds;
    LAS float* knew = qrot + 384;
    LAS float* vnew = knew + 1536;
    LAS float* mw = vnew + 1536;
    LAS float* lw = mw + 8;
    LAS float* ow = lw + 8;
    __syncthreads();
    for (int i = TID; i < 3 * 64; i += NTHR) { const int g = i >> 6, f = i & 63; const float* zr = ZS + (size_t)(b * 4 + t) * DIN + OFF_QB + g * 512 + h * 128;
        const float x1 = zr[f], x2 = zr[64 + f], c = rope[((size_t)(2048 + t) * 64 + f) * 2], s = rope[((size_t)(2048 + t) * 64 + f) * 2 + 1];
        qrot[g * 128 + f] = (x1 * c - x2 * s) * SQ_ATT; qrot[g * 128 + 64 + f] = (x2 * c + x1 * s) * SQ_ATT; }
    for (int i = TID; i < 3 * 4 * 64; i += NTHR) { const int g = i >> 8, tt = (i >> 6) & 3, f = i & 63; const float* zr = ZS + (size_t)(b * 4 + tt) * DIN + OFF_KB + g * 512 + h * 128;
        const float x1 = zr[f], x2 = zr[64 + f], c = rope[((size_t)(2048 + tt) * 64 + f) * 2], s = rope[((size_t)(2048 + tt) * 64 + f) * 2 + 1];
        knew[(g * 4 + tt) * 128 + f] = x1 * c - x2 * s; knew[(g * 4 + tt) * 128 + 64 + f] = x2 * c + x1 * s; }
    for (int i = TID; i < 3 * 4 * 128; i += NTHR) { const int g = i >> 9, tt = (i >> 7) & 3, d = i & 127; vnew[i] = ZS[(size_t)(b * 4 + tt) * DIN + OFF_VB + g * 512 + h * 128 + d]; }
    __syncthreads();
    for (int i = TID; i < 3 * 256; i += NTHR) { const int g = i >> 8, kv = (i >> 7) & 1, d = i & 127, L = 128 << (2 * g);
        float* o = out + (g == 0 ? O_W1S : g == 1 ? O_W2S : O_W3S) + (((size_t)(l * NBS + b) * L + (L - 4 + t)) * 2 + kv) * 512 + h * 128 + d;
        *o = kv == 0 ? knew[(g * 4 + t) * 128 + d] : vnew[(g * 4 + t) * 128 + d]; }
    float m = -1e30f, ls = 0.f, o0 = 0.f, o1 = 0.f;
    const int d0 = 2 * LANE;
#pragma unroll
    for (int g = 0; g < 3; ++g) {
        const int dil = 1 << (2 * g), L = 128 << (2 * g), jmin = g == 0 ? t + 1 : 1;
        const float q0 = qrot[g * 128 + d0], q1 = qrot[g * 128 + d0 + 1];
        if (C.wave == 0) {
            for (int j = 0; j < jmin; ++j) { const int tn = t - dil * j;
                const float k0 = knew[(g * 4 + tn) * 128 + d0], k1 = knew[(g * 4 + tn) * 128 + d0 + 1], v0 = vnew[(g * 4 + tn) * 128 + d0], v1 = vnew[(g * 4 + tn) * 128 + d0 + 1];
                const float s = wave_sum(q0 * k0 + q1 * k1), mn = fmaxf(m, s), corr = __builtin_amdgcn_exp2f(m - mn), p = __builtin_amdgcn_exp2f(s - mn);
                ls = ls * corr + p; o0 = o0 * corr + p * v0; o1 = o1 * corr + p * v1; m = mn; }
        }
        const float* cb = (g == 0 ? in[3] : g == 1 ? in[4] : in[5]) + (size_t)(l * NBS + b) * L * 1024 + h * 128 + d0;
        for (int j0 = jmin + C.wave; j0 <= 128; j0 += 32) {
            f32x2 kk[4], vv[4];
#pragma unroll
            for (int u = 0; u < 4; ++u) { const int j = j0 + 8 * u, jc = j <= 128 ? j : 128; const float* kp = cb + (size_t)(L + t - dil * jc) * 1024; kk[u] = *(const f32x2*)kp; vv[u] = *(const f32x2*)(kp + 512); }
#pragma unroll
            for (int u = 0; u < 4; ++u) { float s = wave_sum(q0 * kk[u][0] + q1 * kk[u][1]); if (j0 + 8 * u > 128) s = -1e30f;
                const float mn = fmaxf(m, s), corr = __builtin_amdgcn_exp2f(m - mn), p = __builtin_amdgcn_exp2f(s - mn);
                ls = ls * corr + p; o0 = o0 * corr + p * vv[u][0]; o1 = o1 * corr + p * vv[u][1]; m = mn; }
        }
    }
    if (LANE == 0) { mw[C.wave] = m; lw[C.wave] = ls; }
    ow[C.wave * 128 + d0] = o0; ow[C.wave * 128 + d0 + 1] = o1;
    __syncthreads();
    if (TID < 128) { float M = -1e30f;
#pragma unroll
        for (int w = 0; w < 8; ++w) M = fmaxf(M, mw[w]);
        float num = 0.f, den = 0.f;
#pragma unroll
        for (int w = 0; w < 8; ++w) { const float e = __builtin_amdgcn_exp2f(mw[w] - M); num += e * ow[w * 128 + TID]; den += e * lw[w]; }
        Y[((size_t)MP + b * 4 + t) * DM + WA + h * 128 + TID] = (bf16)f2bf(num / den); }
}

__device__ __forceinline__ void ret_s_unit(const Ctx& C, int uidx, int l, const float* ZS, const float* rope, bf16* Y, const float* const* in, float* out) {
    DECL_TID
    const int h = uidx & 3, b = uidx >> 2;
    LAS float* qs = (LAS float*)C.lds;
    LAS float* ks = qs + 512;
    LAS float* vs = ks + 512;
    LAS float* cp = vs + 1024;
    LAS float* aa = cp + 2048;
    LAS float* oo = aa + 16;
    __syncthreads();
    for (int i = TID; i < 4 * 64; i += NTHR) { const int tt = i >> 6, f = i & 63; const float* zr = ZS + (size_t)(b * 4 + tt) * DIN;
        const float c = rope[((size_t)(2048 + tt) * 64 + f) * 2], s = rope[((size_t)(2048 + tt) * 64 + f) * 2 + 1];
        float x1 = zr[OFF_QC + h * 128 + f], x2 = zr[OFF_QC + h * 128 + 64 + f]; qs[tt * 128 + f] = x1 * c - x2 * s; qs[tt * 128 + 64 + f] = x2 * c + x1 * s;
        x1 = zr[OFF_KC + h * 128 + f]; x2 = zr[OFF_KC + h * 128 + 64 + f]; ks[tt * 128 + f] = (x1 * c - x2 * s) * KS_RET; ks[tt * 128 + 64 + f] = (x2 * c + x1 * s) * KS_RET; }
    for (int i = TID; i < 1024; i += NTHR) vs[i] = ZS[(size_t)(b * 4 + (i >> 8)) * DIN + OFF_VC + h * 256 + (i & 255)];
    __syncthreads();
    const float g1 = __builtin_amdgcn_exp2f(lg2_gamma(h)), g2 = g1 * g1, g3 = g2 * g1, g4 = g2 * g2;
    const int e = TID & 255, dh = TID >> 8;
    { const float v0 = vs[e], v1 = vs[256 + e], v2 = vs[512 + e], v3 = vs[768 + e];
      float cr[4] = {0.f, 0.f, 0.f, 0.f};
      const size_t sbase = ((size_t)(l * NBS + b) * NHC + h) * 32768;
      const float* sp = in[6] + sbase; float* so = out + O_RS + sbase;
#pragma unroll 8
      for (int d = dh * 64; d < dh * 64 + 64; ++d) { const float S = sp[(size_t)d * 256 + e];
          cr[0] += qs[d] * S; cr[1] += qs[128 + d] * S; cr[2] += qs[256 + d] * S; cr[3] += qs[384 + d] * S;
          so[(size_t)d * 256 + e] = g4 * S + (g3 * ks[d] * v0 + g2 * ks[128 + d] * v1) + (g1 * ks[256 + d] * v2 + ks[384 + d] * v3); }
#pragma unroll
      for (int n = 0; n < 4; ++n) cp[(dh * 4 + n) * 256 + e] = cr[n]; }
    if (TID < 16) { const int n = TID >> 2, mm = TID & 3; float a = 0.f; for (int d = 0; d < 128; ++d) a += qs[n * 128 + d] * ks[mm * 128 + d]; aa[TID] = a; }
    __syncthreads();
    { const float v[4] = {vs[e], vs[256 + e], vs[512 + e], vs[768 + e]};
#pragma unroll
      for (int k = 0; k < 2; ++k) { const int n = 2 * dh + k; float gp = 1.f, o = 0.f;
#pragma unroll
          for (int mm = 3; mm >= 0; --mm) if (mm <= n) { o += gp * aa[n * 4 + mm] * v[mm]; gp *= g1; }
          oo[n * 256 + e] = o + gp * (cp[n * 256 + e] + cp[(4 + n) * 256 + e]); } }
    __syncthreads();
    if (C.wave < 4) { const int n = C.wave; const f32x4 v = *(const LAS f32x4*)(oo + n * 256 + 4 * LANE);
        const float mean = wave_sum((v[0] + v[1]) + (v[2] + v[3])) * (1.0f / 256.0f); const f32x4 d = v - mean;
        const float var = wave_sum((d[0] * d[0] + d[1] * d[1]) + (d[2] * d[2] + d[3] * d[3])) * (1.0f / 256.0f); const float rstd = 1.0f / sqrtf(var + LN_EPS);
        const f32x4 gt = *(const f32x4*)(ZS + (size_t)(b * 4 + n) * DIN + OFF_GC + h * 256 + 4 * LANE);
        v2u w; w.x = pk2(silu_f(gt[0]) * d[0] * rstd, silu_f(gt[1]) * d[1] * rstd); w.y = pk2(silu_f(gt[2]) * d[2] * rstd, silu_f(gt[3]) * d[3] * rstd);
        *(v2u*)(Y + ((size_t)MP + b * 4 + n) * DM + 1024 + h * 256 + 4 * LANE) = w; }
}

__device__ __forceinline__ void ret_out_unit(const Ctx& C, int uidx, const bf16* Z, const bf16* SPREV, bf16* Y) {
    DECL_TID
    const int c = uidx & 15, bh = uidx >> 4, h = bh & 3, b = bh >> 2;
    const int fr = LANE & 15, fq = LANE >> 4, wave = C.wave;
    constexpr int PV = 528;
    LAS unsigned char* Simg = C.lds; LAS unsigned char* Vimg = C.lds + 128 * PV;
    const size_t row0 = (size_t)b * SEQ + c * 128;
    const bf16* zr = Z + row0 * DIN;
    const float lg = lg2_gamma(h);
    __syncthreads();
    if (c > 0) { const bf16* sp = SPREV + ((size_t)bh * NCH + c) * 32768;
#pragma unroll
        for (int i = 0; i < 8; ++i) { const int q = TID + NTHR * i, row = q >> 5, ch = q & 31; *(LAS v4u*)(Simg + row * PV + ch * 16) = *(const v4u*)(sp + (size_t)row * 256 + ch * 8); } }
#pragma unroll
    for (int i = 0; i < 8; ++i) { const int q = TID + NTHR * i, row = q >> 5, ch = q & 31;
        *(LAS v4u*)(Vimg + row * PV + ch * 16) = *(const v4u*)(zr + (size_t)row * DIN + OFF_VC + h * 256 + ch * 8); }
    __syncthreads();
    const int n = 16 * wave + fr;
    bf16x8 qf[4];
#pragma unroll
    for (int s = 0; s < 4; ++s) qf[s] = *(const bf16x8*)(zr + (size_t)n * DIN + OFF_QC + h * 128 + 32 * s + 8 * fq);
    f32x4 o[16];
#pragma unroll
    for (int i = 0; i < 16; ++i) o[i] = (f32x4){0.f, 0.f, 0.f, 0.f};
    if (c > 0) {
#pragma unroll
        for (int s = 0; s < 4; ++s) { const int k0 = 32 * s + 8 * fq;
#pragma unroll
            for (int dvt = 0; dvt < 16; ++dvt) { const bf16x8 a = tr8(Simg, PV, k0, k0 + 4, 16 * dvt, LANE); o[dvt] = MFMA16(a, qf[s], o[dvt]); } }
        const float g1 = __builtin_amdgcn_exp2f(lg);
#pragma unroll
        for (int i = 0; i < 16; ++i) o[i] = o[i] * g1;
    }
#pragma unroll
    for (int s2 = 0; s2 < 4; ++s2) {
        if (2 * s2 <= wave) {
            f32x4 p0 = (f32x4){0.f, 0.f, 0.f, 0.f}, p1 = p0;
            { const bf16* kp = zr + (size_t)(32 * s2 + fr) * DIN + OFF_KC + h * 128 + 8 * fq;
#pragma unroll
              for (int s = 0; s < 4; ++s) { const bf16x8 a = *(const bf16x8*)(kp + 32 * s); p0 = MFMA16(a, qf[s], p0); }
#pragma unroll
              for (int i = 0; i < 4; ++i) p0[i] = (32 * s2 + 4 * fq + i <= n) ? p0[i] : 0.f; }
            if (2 * s2 + 1 <= wave) { const bf16* kp = zr + (size_t)(32 * s2 + 16 + fr) * DIN + OFF_KC + h * 128 + 8 * fq;
#pragma unroll
              for (int s = 0; s < 4; ++s) { const bf16x8 a = *(const bf16x8*)(kp + 32 * s); p1 = MFMA16(a, qf[s], p1); }
#pragma unroll
              for (int i = 0; i < 4; ++i) p1[i] = (32 * s2 + 16 + 4 * fq + i <= n) ? p1[i] : 0.f; }
            const bf16x8 pb = pack8(p0, p1);
#pragma unroll
            for (int dvt = 0; dvt < 16; ++dvt) { const bf16x8 a = tr8(Vimg, PV, 32 * s2 + 4 * fq, 32 * s2 + 16 + 4 * fq, 16 * dvt, LANE); o[dvt] = MFMA16(a, pb, o[dvt]); }
        }
    }
    float s = 0.f;
#pragma unroll
    for (int i = 0; i < 16; ++i) s += (o[i][0] + o[i][1]) + (o[i][2] + o[i][3]);
    s += __shfl_xor(s, 16); s += __shfl_xor(s, 32);
    const float mean = s * (1.0f / 256.0f); float q = 0.f;
#pragma unroll
    for (int i = 0; i < 16; ++i) { o[i] = o[i] - mean; q += (o[i][0] * o[i][0] + o[i][1] * o[i][1]) + (o[i][2] * o[i][2] + o[i][3] * o[i][3]); }
    q += __shfl_xor(q, 16); q += __shfl_xor(q, 32);
    const float rstd = 1.0f / sqrtf(q * (1.0f / 256.0f) + LN_EPS);
    const bf16* gp = zr + (size_t)n * DIN + OFF_GC + h * 256 + 4 * fq; bf16* yp = Y + (row0 + n) * DM + 1024 + h * 256 + 4 * fq;
#pragma unroll
    for (int i = 0; i < 16; ++i) { const v2u gw = *(const v2u*)(gp + 16 * i);
        v2u w; w.x = pk2(silu_f(bflo(gw.x)) * o[i][0] * rstd, silu_f(bfhi(gw.x)) * o[i][1] * rstd); w.y = pk2(silu_f(bflo(gw.y)) * o[i][2] * rstd, silu_f(bfhi(gw.y)) * o[i][3] * rstd);
        *(v2u*)(yp + 16 * i) = w; }
}
__device__ __forceinline__ void attn_merge_rows(const Ctx& C, const bf16* ATTO, const float* ATTL, bf16* Y) {
    DECL_TID
    const int gw = C.bid * NWAVES + C.wave, NGW = C.G * NWAVES, hh = LANE >> 4;
    for (int r = gw; r < MP; r += NGW) {
        const float l0 = ATTL[((size_t)0 * MP + r) * 4 + hh], l1 = ATTL[((size_t)1 * MP + r) * 4 + hh], l2 = ATTL[((size_t)2 * MP + r) * 4 + hh];
        const float mx = fmaxf(l0, fmaxf(l1, l2));
        float w0 = __builtin_amdgcn_exp2f(l0 - mx), w1 = __builtin_amdgcn_exp2f(l1 - mx), w2 = __builtin_amdgcn_exp2f(l2 - mx);
        const float inv = 1.0f / (w0 + w1 + w2); w0 *= inv; w1 *= inv; w2 *= inv;
        const v4u a = *(const v4u*)(ATTO + ((size_t)0 * MP + r) * 512 + 8 * LANE), bq = *(const v4u*)(ATTO + ((size_t)1 * MP + r) * 512 + 8 * LANE), cq = *(const v4u*)(ATTO + ((size_t)2 * MP + r) * 512 + 8 * LANE);
        v4u o;
        o.x = pk2(w0 * bflo(a.x) + w1 * bflo(bq.x) + w2 * bflo(cq.x), w0 * bfhi(a.x) + w1 * bfhi(bq.x) + w2 * bfhi(cq.x));
        o.y = pk2(w0 * bflo(a.y) + w1 * bflo(bq.y) + w2 * bflo(cq.y), w0 * bfhi(a.y) + w1 * bfhi(bq.y) + w2 * bfhi(cq.y));
        o.z = pk2(w0 * bflo(a.z) + w1 * bflo(bq.z) + w2 * bflo(cq.z), w0 * bfhi(a.z) + w1 * bfhi(bq.z) + w2 * bfhi(cq.z));
        o.w = pk2(w0 * bflo(a.w) + w1 * bflo(bq.w) + w2 * bflo(cq.w), w0 * bfhi(a.w) + w1 * bfhi(bq.w) + w2 * bfhi(cq.w));
        *(v4u*)(Y + (size_t)r * DM + WA + 8 * LANE) = o;
    }
}
#ifndef PHMASK
#define PHMASK 0xFFFFFFu
#endif
#define PM(k) ((PHMASK >> (k)) & 1u)
constexpr int NPH = 2 + 8 * DEPTH;
struct Args { const float* in[23]; float* out; unsigned char* ws; int ph_lo, ph_hi; };
static_assert(sizeof(Args) == 23 * 8 + 8 + 8 + 8, "Args has no padding");

__global__ void __launch_bounds__(NTHR, 2) fwd(Args args) {
    extern __shared__ __attribute__((aligned(16))) unsigned char lds_raw[];
    Ctx C;
    C.lds = (LAS unsigned char*)lds_raw;
    C.wave = __builtin_amdgcn_readfirstlane((int)(threadIdx.x >> 6)); C.bid = blockIdx.x; C.G = gridDim.x;
    volatile LAS unsigned* MISC = (volatile LAS unsigned*)(C.lds + MISC_OFF);
    for (int u = (int)threadIdx.x; u < (LDS_BYTES - MISC_OFF) / 4; u += NTHR) MISC[u] = 0u;
    __syncthreads();
    unsigned char* ws = args.ws; float* out = args.out; const float* const* in = args.in;
    XcdBarrier bar = xcd_barrier_post((unsigned*)(ws + WS_CTL) + CW_BAR, MISC + 8);
    const int lo = args.ph_lo, hi = args.ph_hi;
#define IN(k) (lo <= (k) && (k) < hi)
#define SEAM(k) do { if (IN(k) && IN((k) + 1)) xcd_barrier(bar); } while (0)

    float* mod = (float*)(ws + WS_MOD); float* rope = (float*)(ws + WS_ROPE);
    bf16* H = (bf16*)(ws + WS_H); bf16* Z = (bf16*)(ws + WS_Z); bf16* Y = (bf16*)(ws + WS_Y); unsigned char* F = ws + WS_F;
    float* X = (float*)(ws + WS_X); bf16* ATTO = (bf16*)(ws + WS_ATTO); float* ATTL = (float*)(ws + WS_ATTL); bf16* SPREV = (bf16*)(ws + WS_KV);
    float* ZS = (float*)(ws + WS_ZS); float* TSr = (float*)(ws + WS_TS); unsigned char* FS = ws + WS_FS;

    if (PM(0) && IN(0)) { for (int rep = 0; rep < 1 + DUP(0); ++rep) phase_mod(C, in[7], in[8], in[9], in[10], mod, rope, in[19], (unsigned*)(ws + WS_CTL) + CW_AMAX_UP, in[11], (unsigned*)(ws + WS_CTL) + CW_AMAX_IN); }
    SEAM(0);
    if (PM(1) && IN(1)) { for (int rep = 0; rep < 1 + DUP(1); ++rep) phase_prep(C, in, out, ws); }
    SEAM(1);

    for (int l = 0; l < DEPTH; ++l) {
        const int pb = 2 + 8 * l;
        const bf16* Wi = (const bf16*)(ws + WS_WIN) + (size_t)l * NIN16 * DM; const unsigned char* Wi8 = ws + WS_WIN8 + (size_t)l * NIN8 * DM; const float* wsci = (const float*)(ws + WS_CTL) + CW_AMAX_IN + l * NIN8; const bf16* Wo = (const bf16*)(ws + WS_WO) + (size_t)l * DM * DM;
        const unsigned char* Wu = ws + WS_WUP + (size_t)l * DFF * DM; const float* wsc = (const float*)(ws + WS_CTL) + CW_AMAX_UP + l * DFF; const unsigned char* Wd = ws + WS_WDN + (size_t)l * DM * DFF;
        if (PM(2) && IN(pb + 0)) for (int rep = 0; rep < 1 + DUP(2); ++rep) {
            const unsigned char* H8 = ws + WS_H8; const float* hsc = (const float*)(ws + WS_HSC);
            mini_gemm<0>(C, H + (size_t)MP * DM, DM, Wi, NIN16, DM, ZS, DIN);
            mini_gemm_i8<1>(C, H8 + (size_t)MP * DM, DM, hsc + MP, Wi8, wsci, NIN8, DM, ZS, DIN);
            {
                pg8::Gemm g{H, Wi, MP, NIN16, DM}; pg8::StaticOrder S; S.init(MP, NIN16, C.G, C.bid);
                pg8::EpiZ<false> E{Z, rope, out, l, hsc, wsci};
                pg8::gemm_phase<pg8::EpiZ<false>, pg8::StaticOrder, true, true>(C.lds, g, S, E);
            }
            {
                pg8::Gemm g{(const bf16*)H8, (const bf16*)Wi8, MP, NIN8, DM / 2}; pg8::SplitOrder S; S.init(MP, NIN8, C.G, C.bid, (MP / 256) * (NIN16 / 256));
                pg8::EpiZ<true> E{Z, rope, out, l, hsc, wsci};
                pg8::gemm_phase<pg8::EpiZ<true>, pg8::SplitOrder, true, true, 2>(C.lds, g, S, E);
            }
        }
        SEAM(pb + 0);
        if (PM(3) && IN(pb + 1)) for (int rep = 0; rep < 1 + DUP(3); ++rep) {
            for (int u = C.bid; u < 1320; u += C.G) {
                if (u < 768) { if (PM(10)) attn_unit(C, u, Z, ATTO, ATTL); }
                else if (u < 896) { if (PM(11)) ret_scan_unit(C, u - 768, l, Z, SPREV, out); }
                else if (u < 1152) { if (PM(12)) conv_unit(C, u - 896, l, Z, Y, in); }
                else if (u < 1160) { if (PM(13)) conv_s_unit(C, u - 1152, l, ZS, Y, in, out); }
                else if (u < 1288) { if (PM(14)) attn_s_unit(C, u - 1160, l, ZS, rope, Y, in, out); }
                else { if (PM(15)) ret_s_unit(C, u - 1288, l, ZS, rope, Y, in, out); }
            }
        }
        SEAM(pb + 1);
        if (PM(4) && IN(pb + 2)) for (int rep = 0; rep < 1 + DUP(4); ++rep) {
            for (int u = C.bid; u < 256; u += C.G) { if (PM(16)) ret_out_unit(C, u, Z, SPREV, Y); }
            if (PM(18)) attn_merge_rows(C, ATTO, ATTL, Y);
        }
        SEAM(pb + 2);
        if (PM(5) && IN(pb + 3)) for (int rep = 0; rep < 1 + DUP(5); ++rep) {
            __syncthreads();
            mini_gemm<1>(C, Y + (size_t)MP * DM, DM, Wo, DM, DM, TSr, DM);
            pg8::Gemm g{Y, Wo, MP, DM, DM}; pg8::StaticOrder S; S.init(MP, DM, C.G, C.bid);
            pg8::EpiRes E{l == 0 ? in[0] : X, rep < DUP(5) ? (float*)(ws + WS_X2) : X, mod + (size_t)l * 12 * 12288 + 2 * 2048, 1.0f};
            pg8::gemm_phase<pg8::EpiRes, pg8::StaticOrder, true, true>(C.lds, g, S, E);
        }
        SEAM(pb + 3);
        if (PM(6) && IN(pb + 4)) for (int rep = 0; rep < 1 + DUP(6); ++rep) phase_ln(C, l, 1, in, out, ws, rep < DUP(6));
        SEAM(pb + 4);
        if (PM(7) && IN(pb + 5)) for (int rep = 0; rep < 1 + DUP(7); ++rep) {
            const unsigned char* H8 = ws + WS_H8; const float* hsc = (const float*)(ws + WS_HSC);
            mini_gemm_i8<0>(C, H8 + (size_t)MP * DM, DM, hsc + MP, Wu, wsc, DFF, DM, FS, DFF);
            pg8::Gemm g{(const bf16*)H8, (const bf16*)Wu, MP, DFF, DM / 2}; pg8::StaticOrder S; S.init(MP, DFF, C.G, C.bid);
            pg8::EpiUp E{F, hsc, wsc};
            pg8::gemm_phase<pg8::EpiUp, pg8::StaticOrder, true, true, 2>(C.lds, g, S, E);
        }
        SEAM(pb + 5);
        if (PM(8) && IN(pb + 6)) for (int rep = 0; rep < 1 + DUP(8); ++rep) {
            mini_gemm_fp8(C, FS, DFF, Wd, DM, DFF, TSr, DM, 1.0f / WDN_SCALE);
            pg8::Gemm g{(const bf16*)F, (const bf16*)Wd, MP, DM, DFF / 2}; pg8::StaticOrder S; S.init(MP, DM, C.G, C.bid);
            pg8::EpiRes E{X, rep < DUP(8) ? (float*)(ws + WS_X2) : X, mod + (size_t)l * 12 * 12288 + 5 * 2048, 1.0f / WDN_SCALE};
            pg8::gemm_phase<pg8::EpiRes, pg8::StaticOrder, true, true, 1>(C.lds, g, S, E);
        }
        SEAM(pb + 6);
        if (PM(9) && IN(pb + 7)) for (int rep = 0; rep < 1 + DUP(9); ++rep) phase_ln(C, l, 2, in, out, ws, rep < DUP(9));
        SEAM(pb + 7);
    }
#undef IN
#undef SEAM
}

extern "C" void kernel_launch(void* const* d_in, const int* in_sizes, int n_in, void* d_out, int out_size, void* d_ws, size_t ws_size, hipStream_t stream) {
    static int grid = 0;
    if (grid == 0) {
        if (n_in != 23 || (size_t)out_size != O_END || ws_size < WS_END) { fprintf(stderr, "kernel_launch: unexpected sizes n_in %d out %d ws %zu\n", n_in, out_size, ws_size); grid = -1; return; }
        int dev = 0, cus = 0, per_cu = 0;
        if (hipGetDevice(&dev) != hipSuccess || hipDeviceGetAttribute(&cus, hipDeviceAttributeMultiprocessorCount, dev) != hipSuccess) { grid = -1; return; }
        if (hipFuncSetAttribute((const void*)fwd, hipFuncAttributeMaxDynamicSharedMemorySize, LDS_BYTES) != hipSuccess) { fprintf(stderr, "kernel_launch: hipFuncSetAttribute failed\n"); grid = -1; return; }
        if (hipOccupancyMaxActiveBlocksPerMultiprocessor(&per_cu, (const void*)fwd, NTHR, LDS_BYTES) != hipSuccess || per_cu < 1) fprintf(stderr, "kernel_launch: occupancy query reports %d\n", per_cu);
        (void)hipGetLastError();
        grid = cus;
    }
    if (grid < 0) return;
    (void)hipMemsetAsync((char*)d_ws + WS_CTL, 0, CTL_ZERO_BYTES, stream);
    Args a{};
    for (int i = 0; i < 23; ++i) a.in[i] = (const float*)d_in[i];
    a.out = (float*)d_out; a.ws = (unsigned char*)d_ws;
#if MK_ONE_LAUNCH
    a.ph_lo = 0; a.ph_hi = NPH;
    hipLaunchKernelGGL(fwd, dim3(grid), dim3(NTHR), LDS_BYTES, stream, a);
#else
    for (int p = 0; p < NPH; ++p) { a.ph_lo = p; a.ph_hi = p + 1; hipLaunchKernelGGL(fwd, dim3(grid), dim3(NTHR), LDS_BYTES, stream, a); }
#endif
}
```
